# Optimizing an MI355X kernel written in HIP

```python
import jax, jax.numpy as jnp
from jax import lax
import numpy as np

D_MODEL = 2048
BATCH = 2
SEQ = 4096
DEPTH = 1

MEM_LEN = 256
RMS_EPS = 1e-6

MLSTM_HEADS = 4
MLSTM_WIDTH = D_MODEL // 2
MLSTM_V_DIM = MLSTM_WIDTH // MLSTM_HEADS
MLSTM_QK_DIM = MLSTM_V_DIM // 2
MLSTM_QK_WIDTH = MLSTM_HEADS * MLSTM_QK_DIM
MLSTM_CHUNK = 64
GATE_SOFTCAP = 15.0

RWKV_WIDTH = D_MODEL // 2
RWKV_HEAD = 64
RWKV_HEADS = RWKV_WIDTH // RWKV_HEAD
RWKV_DECAY_RANK = 64
RWKV_A_RANK = 64
RWKV_GATE_RANK = 160
RWKV_GN_EPS = 64e-5

MLSTM_COLS = (MLSTM_QK_WIDTH, MLSTM_QK_WIDTH, MLSTM_WIDTH, MLSTM_WIDTH, MLSTM_HEADS, MLSTM_HEADS)
RWKV_COLS = (RWKV_WIDTH, RWKV_WIDTH, RWKV_WIDTH, RWKV_DECAY_RANK, RWKV_A_RANK, RWKV_GATE_RANK)
MLSTM_TOTAL = sum(MLSTM_COLS)
RWKV_TOTAL = sum(RWKV_COLS)
GATE_TOTAL = 2 * D_MODEL
IN_COLS = MLSTM_TOTAL + RWKV_TOTAL + GATE_TOTAL

XATTN_HEADS = 4
XATTN_HEAD_DIM = 128
XATTN_WIDTH = XATTN_HEADS * XATTN_HEAD_DIM

D_FF = 4 * D_MODEL
CONV_WIDTH = 3

kernel_name = "hybrid_mlstm_rwkv7_gated_xattn_convffn"


def rms_norm(x, g):
    xf = x.astype(jnp.float32)
    y = xf * lax.rsqrt(jnp.mean(xf * xf, axis=-1, keepdims=True) + RMS_EPS)
    return (y * g).astype(x.dtype)


def split_cols(t, sizes):
    idx = [int(i) for i in np.cumsum(sizes)[:-1]]
    return jnp.split(t, idx, axis=-1)


def shift_right(t, n):
    return jnp.pad(t, ((0, 0), (n, 0), (0, 0)))[:, : t.shape[1]]


def softcap(t, cap):
    return cap * jnp.tanh(t / cap)


def mlstm_chunkwise(q, k, v, ig, logf):
    B, S, H, dk = q.shape
    dv = v.shape[-1]
    L = MLSTM_CHUNK
    NC = S // L

    def to_chunks(t):
        return t.reshape(B, NC, L, H, t.shape[-1]).transpose(1, 0, 3, 2, 4)

    def gate_chunks(t):
        return t.reshape(B, NC, L, H).transpose(1, 0, 3, 2)

    causal = jnp.tril(jnp.ones((L, L), dtype=bool))

    def body(carry, inp):
        C, n, m = carry
        qc, kc, vc, ic, fc = inp
        b = jnp.cumsum(fc, axis=-1)
        dmat = jnp.where(causal, b[..., :, None] - b[..., None, :] + ic[..., None, :], -jnp.inf)
        inter = b + m[..., None]
        m_t = jnp.maximum(inter, jnp.max(dmat, axis=-1))
        dexp = jnp.exp(dmat - m_t[..., None])
        w_inter = jnp.exp(inter - m_t)
        s = jnp.einsum('bhtd,bhsd->bhts', qc, kc) * dexp
        num = w_inter[..., None] * jnp.einsum('bhvd,bhtd->bhtv', C, qc) + jnp.einsum('bhts,bhsv->bhtv', s, vc)
        den = w_inter * jnp.einsum('bhd,bhtd->bht', n, qc) + jnp.sum(s, axis=-1)
        h = num / jnp.maximum(jnp.abs(den), jnp.exp(-m_t))[..., None]
        bL = b[..., -1]
        gs = bL[..., None] - b + ic
        m_new = jnp.maximum(bL + m, jnp.max(gs, axis=-1))
        carry_w = jnp.exp(bL + m - m_new)
        ws = jnp.exp(gs - m_new[..., None])
        C = carry_w[..., None, None] * C + jnp.einsum('bhs,bhsv,bhsd->bhvd', ws, vc, kc)
        n = carry_w[..., None] * n + jnp.einsum('bhs,bhsd->bhd', ws, kc)
        return (C, n, m_new), h

    init = (jnp.zeros((B, H, dv, dk), jnp.float32), jnp.zeros((B, H, dk), jnp.float32), jnp.zeros((B, H), jnp.float32))
    _, h = lax.scan(body, init, (to_chunks(q), to_chunks(k), to_chunks(v), gate_chunks(ig), gate_chunks(logf)))
    return h.transpose(1, 0, 3, 2, 4).reshape(B, S, H, dv)


def rwkv7_scan(r, w, k, v, kk, kka):
    B, S, H, N = r.shape

    def step(state, inp):
        rt, wt, kt, vt, kkt, kat = inp
        state = (state * wt[:, :, None, :]
                 - jnp.einsum('bhvk,bhk->bhv', state, kkt)[..., None] * kat[:, :, None, :]
                 + vt[..., None] * kt[:, :, None, :])
        return state, jnp.einsum('bhvk,bhk->bhv', state, rt)

    seq_major = lambda t: t.transpose(1, 0, 2, 3)
    init = jnp.zeros((B, H, N, N), jnp.float32)
    _, y = lax.scan(step, init, tuple(seq_major(t) for t in (r, w, k, v, kk, kka)))
    return y.transpose(1, 0, 2, 3)


def hybrid_mixer(h, w_in, b_i, b_f, head_norm, mu, w0, w_up, a0, a_up, g_up, k_k, k_a, r_k, ln_g, ln_b,
                 w_branch_a, w_branch_b, w_out):
    B, S, _ = h.shape
    f32 = jnp.float32
    proj = h @ w_in
    mlstm_p, rwkv_p, gate_p = split_cols(proj, (MLSTM_TOTAL, RWKV_TOTAL, GATE_TOTAL))

    q, k, v, o, ir, fr = split_cols(mlstm_p, MLSTM_COLS)
    q = q.reshape(B, S, MLSTM_HEADS, MLSTM_QK_DIM).astype(f32)
    k = k.reshape(B, S, MLSTM_HEADS, MLSTM_QK_DIM).astype(f32) * (MLSTM_QK_DIM ** -0.5)
    v = v.reshape(B, S, MLSTM_HEADS, MLSTM_V_DIM).astype(f32)
    ig = softcap((ir + b_i).astype(f32), GATE_SOFTCAP)
    logf = jax.nn.log_sigmoid(softcap((fr + b_f).astype(f32), GATE_SOFTCAP))
    hm = mlstm_chunkwise(q, k, v, ig, logf)
    hm = hm * lax.rsqrt(jnp.mean(hm * hm, axis=-1, keepdims=True) + RMS_EPS) * head_norm.reshape(MLSTM_HEADS, MLSTM_V_DIM)
    ha = (jax.nn.sigmoid(o.astype(f32)) * hm.reshape(B, S, MLSTM_WIDTH)).astype(h.dtype)

    rp = rwkv_p + (shift_right(rwkv_p, 1) - rwkv_p) * mu
    r, kr, vr, wl, al, gl = split_cols(rp, RWKV_COLS)
    w_log = -jax.nn.softplus(-(w0 + jnp.tanh(wl) @ w_up)) - 0.5
    decay = jnp.exp(-jnp.exp(w_log.astype(f32)))
    a = jax.nn.sigmoid(a0 + al @ a_up)
    g = jax.nn.sigmoid(gl) @ g_up
    heads = lambda t: t.reshape(B, S, RWKV_HEADS, RWKV_HEAD).astype(f32)
    per_head = lambda p: p.reshape(RWKV_HEADS, RWKV_HEAD).astype(f32)
    kk = heads(kr * k_k)
    kk = kk / jnp.maximum(jnp.linalg.norm(kk, axis=-1, keepdims=True), 1e-12)
    a_h = heads(a)
    kr = heads(kr * (1.0 + (a - 1.0) * k_a))
    r_h, v_h = heads(r), heads(vr)
    y = rwkv7_scan(r_h, heads(decay), kr, v_h, kk, kk * a_h)
    mean = jnp.mean(y, axis=-1, keepdims=True)
    var = jnp.mean(jnp.square(y - mean), axis=-1, keepdims=True)
    y = (y - mean) * lax.rsqrt(var + RWKV_GN_EPS) * per_head(ln_g) + per_head(ln_b)
    y = y + jnp.sum(r_h * kr * r_k.astype(f32), axis=-1, keepdims=True) * v_h
    hb = (y.reshape(B, S, RWKV_WIDTH) * g).astype(h.dtype)

    g_a, g_b = split_cols(gate_p, (D_MODEL, D_MODEL))
    merged = jax.nn.sigmoid(g_a) * (ha @ w_branch_a) + jax.nn.sigmoid(g_b) * (hb @ w_branch_b)
    return merged @ w_out


def cross_attention(h, mem_n, wq, wkv, wo):
    B, S, _ = h.shape
    M = mem_n.shape[1]
    q = (h @ wq).reshape(B, S, XATTN_HEADS, XATTN_HEAD_DIM)
    k, v = split_cols(mem_n @ wkv, (XATTN_WIDTH, XATTN_WIDTH))
    k = k.reshape(B, M, XATTN_HEADS, XATTN_HEAD_DIM)
    v = v.reshape(B, M, XATTN_HEADS, XATTN_HEAD_DIM)
    scores = jnp.einsum('bshd,bmhd->bhsm', q, k).astype(jnp.float32) * (XATTN_HEAD_DIM ** -0.5)
    p = jax.nn.softmax(scores, axis=-1).astype(v.dtype)
    o = jnp.einsum('bhsm,bmhd->bshd', p, v).reshape(B, S, XATTN_WIDTH)
    return o @ wo


def conv_glu_ffn(h, w_up, conv_w, conv_b, w_down):
    u = h @ w_up
    uc = conv_b + sum(conv_w[j] * shift_right(u, CONV_WIDTH - 1 - j) for j in range(CONV_WIDTH))
    gate, up = split_cols(uc, (D_FF, D_FF))
    return (jax.nn.gelu(gate, approximate=True) * up) @ w_down


def setup_inputs(seed: int = 0) -> dict:
    key = jax.random.key(seed)
    ks = iter(jax.random.split(key, 40))
    nrm = lambda shape, scale: scale * jax.random.normal(next(ks), shape, jnp.float32)
    gain = lambda n: 1.0 + nrm((DEPTH, n), 0.05)
    Dp = DEPTH
    conv_w = nrm((Dp, CONV_WIDTH, 2 * D_FF), 0.2).at[:, CONV_WIDTH - 1].add(1.0)
    return {
        "x": nrm((BATCH, SEQ, D_MODEL), 1.0),
        "mem": nrm((BATCH, MEM_LEN, D_MODEL), 1.0),
        "mix_pre_norm": gain(D_MODEL),
        "w_in": nrm((Dp, D_MODEL, IN_COLS), D_MODEL ** -0.5),
        "mlstm_b_i": nrm((Dp, MLSTM_HEADS), 0.1),
        "mlstm_b_f": jnp.linspace(3.0, 6.0, MLSTM_HEADS)[None] + nrm((Dp, MLSTM_HEADS), 0.1),
        "mlstm_head_norm": gain(MLSTM_WIDTH),
        "rwkv_mu": jax.random.uniform(next(ks), (Dp, RWKV_TOTAL), jnp.float32),
        "rwkv_w0": (-6.5 + 5.0 * jnp.linspace(0.0, 1.0, RWKV_WIDTH) ** 0.85)[None] + nrm((Dp, RWKV_WIDTH), 0.1),
        "rwkv_w_up": nrm((Dp, RWKV_DECAY_RANK, RWKV_WIDTH), 0.5 * RWKV_DECAY_RANK ** -0.5),
        "rwkv_a0": nrm((Dp, RWKV_WIDTH), 0.1),
        "rwkv_a_up": nrm((Dp, RWKV_A_RANK, RWKV_WIDTH), RWKV_A_RANK ** -0.5),
        "rwkv_g_up": nrm((Dp, RWKV_GATE_RANK, RWKV_WIDTH), RWKV_GATE_RANK ** -0.5),
        "rwkv_k_k": 0.85 + nrm((Dp, RWKV_WIDTH), 0.05),
        "rwkv_k_a": 1.0 + nrm((Dp, RWKV_WIDTH), 0.05),
        "rwkv_r_k": nrm((Dp, RWKV_HEADS, RWKV_HEAD), 0.1),
        "rwkv_ln_g": gain(RWKV_WIDTH),
        "rwkv_ln_b": nrm((Dp, RWKV_WIDTH), 0.02),
        "w_branch_a": nrm((Dp, MLSTM_WIDTH, D_MODEL), MLSTM_WIDTH ** -0.5),
        "w_branch_b": nrm((Dp, RWKV_WIDTH, D_MODEL), RWKV_WIDTH ** -0.5),
        "w_mix_out": nrm((Dp, D_MODEL, D_MODEL), D_MODEL ** -0.5),
        "mix_post_norm": gain(D_MODEL),
        "xattn_pre_norm": gain(D_MODEL),
        "mem_norm": gain(D_MODEL),
        "xattn_wq": nrm((Dp, D_MODEL, XATTN_WIDTH), D_MODEL ** -0.5),
        "xattn_wkv": nrm((Dp, D_MODEL, 2 * XATTN_WIDTH), D_MODEL ** -0.5),
        "xattn_wo": nrm((Dp, XATTN_WIDTH, D_MODEL), XATTN_WIDTH ** -0.5),
        "xattn_post_norm": gain(D_MODEL),
        "ffn_pre_norm": gain(D_MODEL),
        "ffn_w_up": nrm((Dp, D_MODEL, 2 * D_FF), D_MODEL ** -0.5),
        "ffn_conv_w": conv_w,
        "ffn_conv_b": nrm((Dp, 2 * D_FF), 0.02),
        "ffn_w_down": nrm((Dp, D_FF, D_MODEL), D_FF ** -0.5),
        "ffn_post_norm": gain(D_MODEL),
    }


def reference(x, mem, mix_pre_norm, w_in, mlstm_b_i, mlstm_b_f, mlstm_head_norm, rwkv_mu, rwkv_w0, rwkv_w_up,
              rwkv_a0, rwkv_a_up, rwkv_g_up, rwkv_k_k, rwkv_k_a, rwkv_r_k, rwkv_ln_g, rwkv_ln_b, w_branch_a,
              w_branch_b, w_mix_out, mix_post_norm, xattn_pre_norm, mem_norm, xattn_wq, xattn_wkv, xattn_wo,
              xattn_post_norm, ffn_pre_norm, ffn_w_up, ffn_conv_w, ffn_conv_b, ffn_w_down, ffn_post_norm):
    for l in range(DEPTH):
        h = rms_norm(x, mix_pre_norm[l])
        y = hybrid_mixer(h, w_in[l], mlstm_b_i[l], mlstm_b_f[l], mlstm_head_norm[l], rwkv_mu[l], rwkv_w0[l],
                         rwkv_w_up[l], rwkv_a0[l], rwkv_a_up[l], rwkv_g_up[l], rwkv_k_k[l], rwkv_k_a[l],
                         rwkv_r_k[l], rwkv_ln_g[l], rwkv_ln_b[l], w_branch_a[l], w_branch_b[l], w_mix_out[l])
        x = x + rms_norm(y, mix_post_norm[l])
        h = rms_norm(x, xattn_pre_norm[l])
        m = rms_norm(mem, mem_norm[l])
        x = x + rms_norm(cross_attention(h, m, xattn_wq[l], xattn_wkv[l], xattn_wo[l]), xattn_post_norm[l])
        h = rms_norm(x, ffn_pre_norm[l])
        x = x + rms_norm(conv_glu_ffn(h, ffn_w_up[l], ffn_conv_w[l], ffn_conv_b[l], ffn_w_down[l]), ffn_post_norm[l])
    return x
```

```cpp
#include <hip/hip_runtime.h>
#include <hip/hip_cooperative_groups.h>
#include <cstdio>
namespace cg = cooperative_groups;

typedef unsigned short bf16_t;
typedef short bf16x8 __attribute__((ext_vector_type(8)));
typedef float f32x4 __attribute__((ext_vector_type(4)));
typedef unsigned u32x2_t __attribute__((ext_vector_type(2)));
typedef unsigned u32x4v_t __attribute__((ext_vector_type(4)));
#define DEVI __device__ __forceinline__

constexpr int TOK = 8192, DM = 2048, SEQ = 4096, NPROJ = 10752, NIN = 10536;
constexpr int LDS_BYTES = 155648;
constexpr size_t MiB = 1048576;

constexpr size_t O_Z      = 0;
constexpr size_t O_SS     = O_Z;
constexpr size_t O_BCUM   = O_Z + 98304;
constexpr size_t O_IG     = O_BCUM + 131072;
constexpr size_t O_GMAX   = O_IG + 131072;
constexpr size_t O_BL     = O_GMAX + 2048;
constexpr size_t O_MST    = O_BL + 2048;
constexpr size_t O_DN     = O_MST + 2048;
constexpr size_t O_NST    = O_DN + 262144;
constexpr size_t O_BAR    = 917504;
constexpr size_t O_KV     = 1 * MiB;
constexpr size_t O_WLR    = 2 * MiB;
constexpr size_t O_WA     = 8 * MiB, O_WB = 12 * MiB, O_WOUT = 16 * MiB, O_WQ = 24 * MiB, O_WKV = 26 * MiB, O_WO = 30 * MiB;
constexpr size_t O_WIN    = 32 * MiB;
constexpr size_t O_HN     = 74 * MiB;
constexpr size_t O_MN     = 106 * MiB;
constexpr size_t O_DC     = 32 * MiB;
constexpr size_t O_MTMP   = 32 * MiB;
constexpr size_t O_Q      = 108 * MiB, O_O = 40 * MiB, O_H2 = 48 * MiB;
constexpr size_t O_PROJ   = 108 * MiB;
constexpr size_t O_TAIL   = 276 * MiB;
constexpr size_t O_RR     = 292 * MiB, O_RK = 308 * MiB, O_RV = 324 * MiB, O_RG = 340 * MiB, O_RKK = 356 * MiB, O_RKA = 372 * MiB, O_RW = 388 * MiB;
constexpr size_t O_HA     = 356 * MiB, O_HB = 372 * MiB;
constexpr size_t O_YS     = 420 * MiB;
constexpr size_t O_MERGED = 420 * MiB;
constexpr size_t O_CST    = 452 * MiB;
constexpr size_t O_Y      = 108 * MiB, O_X1 = 172 * MiB;
constexpr size_t O_X2     = 264 * MiB;
constexpr size_t O_WDN    = 328 * MiB;
constexpr size_t O_WUP    = 360 * MiB;
constexpr size_t O_H3     = 424 * MiB;
constexpr size_t O_U      = 8 * MiB;
constexpr size_t O_ACT    = 360 * MiB;
constexpr size_t O_Y3     = 8 * MiB;

struct Params { const float* in[34]; float* out; char* ws; };

typedef __bf16 bf16v2_t __attribute__((ext_vector_type(2)));
typedef float f32x2_t __attribute__((ext_vector_type(2)));
DEVI unsigned pack2(float a, float b) { const f32x2_t v = {a, b}; const bf16v2_t r = __builtin_convertvector(v, bf16v2_t); return __builtin_bit_cast(unsigned, r); }
DEVI bf16_t f2bf(float f) { return (bf16_t)(pack2(f, 0.f) & 0xffffu); }
DEVI unsigned pack2_sw(float a, float b) {
  unsigned u = __float_as_uint(a), w = __float_as_uint(b); u += 0x7fffu + ((u >> 16) & 1u); w += 0x7fffu + ((w >> 16) & 1u); return (u >> 16) | (w & 0xffff0000u); }
DEVI float bf2f(bf16_t b) { return __uint_as_float(((unsigned)b) << 16); }
DEVI float lo2f(unsigned u) { return __uint_as_float(u << 16); }
DEVI float hi2f(unsigned u) { return __uint_as_float(u & 0xffff0000u); }
DEVI float sigmoidf_(float x) { return 1.f / (1.f + __expf(-x)); }
DEVI float wave_sum(float v) {
#pragma unroll
  for (int o = 1; o < 64; o <<= 1) v += __shfl_xor(v, o);
  return v;
}
DEVI float dpp_sum16(float x);
DEVI float wave_sum_fast(float x) {
  x = dpp_sum16(x);
  const unsigned a = __float_as_uint(x);
  const auto r = __builtin_amdgcn_permlane16_swap(a, a, false, false);
  const float y = __uint_as_float(r[0]) + __uint_as_float(r[1]);
  const unsigned c = __float_as_uint(y);
  const auto q = __builtin_amdgcn_permlane32_swap(c, c, false, false);
  return __uint_as_float(q[0]) + __uint_as_float(q[1]);
}
DEVI float wave_max(float v) {
#pragma unroll
  for (int o = 1; o < 64; o <<= 1) v = fmaxf(v, __shfl_xor(v, o));
  return v;
}
DEVI float sum16(float v) { v += __shfl_xor(v, 1); v += __shfl_xor(v, 2); v += __shfl_xor(v, 4); v += __shfl_xor(v, 8); return v; }
DEVI float max16(float v) { v = fmaxf(v, __shfl_xor(v, 1)); v = fmaxf(v, __shfl_xor(v, 2)); v = fmaxf(v, __shfl_xor(v, 4)); v = fmaxf(v, __shfl_xor(v, 8)); return v; }
DEVI float dpp_sum16(float x) {
  x += __builtin_bit_cast(float, __builtin_amdgcn_update_dpp(0, __builtin_bit_cast(int, x), 0xB1, 0xf, 0xf, true));
  x += __builtin_bit_cast(float, __builtin_amdgcn_update_dpp(0, __builtin_bit_cast(int, x), 0x4E, 0xf, 0xf, true));
  x += __builtin_bit_cast(float, __builtin_amdgcn_update_dpp(0, __builtin_bit_cast(int, x), 0x141, 0xf, 0xf, true));
  x += __builtin_bit_cast(float, __builtin_amdgcn_update_dpp(0, __builtin_bit_cast(int, x), 0x140, 0xf, 0xf, true));
  return x;
}
DEVI int fresh_tid() { int t = threadIdx.x; asm volatile("" : "+v"(t)); return t; }
#define MFMA16(a, b, c) __builtin_amdgcn_mfma_f32_16x16x32_bf16((a), (b), (c), 0, 0, 0)

constexpr int BM = 256, BK = 64, HALF = 128, HT = HALF * BK, NXCD = 8, WGM = 4;
DEVI int lds_byte(int r, int c) { int st = (r >> 4) * 2 + (c >> 5), rr = r & 15, cc = c & 31, ob = rr * 64 + cc * 2; return st * 1024 + (ob ^ (((ob >> 9) & 1) << 5)); }
DEVI void stage_rc(int b, int& R, int& C) { int st = b / 1024, sb = b % 1024, swz = sb ^ (((sb >> 9) & 1) << 5); R = (st >> 1) * 16 + swz / 64; C = (st & 1) * 32 + (swz % 64) / 2; }

struct GD {
  const bf16_t* A; const bf16_t* Bt; int lda, ldb, K, nM, nN, mode, boff;
  void* O; int ldo; float* aux; const bf16_t* gate; float* ss;
};

DEVI bool tile_of(long L, int nM, int nN, int& pm, int& pn) {
  const int nwg = nM * nN; if (L >= nwg) return false;
  int wgid = (int)L; { const int q = nwg / NXCD, r = nwg % NXCD, xcd = wgid % NXCD, off = wgid / NXCD; wgid = (xcd < r ? xcd * (q + 1) : r * (q + 1) + (xcd - r) * q) + off; }
  const int nig = WGM * nN, gid = wgid / nig, fm = gid * WGM, gsz = (nM - fm) < WGM ? (nM - fm) : WGM;
  pm = fm + ((wgid % nig) % gsz); pn = (wgid % nig) / gsz; return true;
}

typedef __attribute__((address_space(3))) unsigned char lds_u8;
template <int MODE>
DEVI void gemm_tile(const GD& d, const int pm, const int pn, lds_u8* lds, const bool staged = false, const bool has_next = false, const int npm = 0, const int npn = 0) {
  const int tid = fresh_tid(), wid = __builtin_amdgcn_readfirstlane(tid >> 6), lane = tid & 63, wr = wid >> 2, wc = wid & 3, fr = lane & 15, fq = lane >> 4;
  const int lda = d.lda, ldb = d.ldb;
  unsigned voffA[2], voffB[2];
#pragma unroll
  for (int i = 0; i < 2; ++i) { int R, C; stage_rc(tid * 16 + i * 8192, R, C); voffA[i] = (unsigned)(R * lda + C) * 2u; voffB[i] = (unsigned)(R * ldb + C) * 2u; }
  const size_t kstep = (size_t)(BK * 2);
  const size_t hstepA = (size_t)HALF * lda * 2, hstepB = (size_t)HALF * ldb * 2;
  const unsigned ldsw = (unsigned)wid * 1024u;
  const int aoff = lds_byte(wr * 64 + fr, fq * 8), boff = lds_byte(wc * 32 + fr, fq * 8);
  constexpr int HTB = HT * 2;
#define SA(b, h) (((b) * 2 + (h)) * HTB)
#define SB(b, h) ((4 + (b) * 2 + (h)) * HTB)
#define STAGE(bufoff, gbase, voff) do { _Pragma("unroll") for (int _i = 0; _i < 2; ++_i) \
    __builtin_amdgcn_global_load_lds((const unsigned*)((const char*)(gbase) + (voff)[_i]), (__attribute__((address_space(3))) unsigned*)(lds + (bufoff) + ldsw + _i * 8192), 16, 0, 0); } while (0)
#define LDA(dst, b, h) do { _Pragma("unroll") for (int m = 0; m < 4; ++m) _Pragma("unroll") for (int k = 0; k < 2; ++k) dst[m][k] = *(const __attribute__((address_space(3))) bf16x8*)(lds + SA(b, h) + aoff + m * 2048 + k * 1024); } while (0)
#define LDB(dst, b, h) do { _Pragma("unroll") for (int n = 0; n < 2; ++n) _Pragma("unroll") for (int k = 0; k < 2; ++k) dst[n][k] = *(const __attribute__((address_space(3))) bf16x8*)(lds + SB(b, h) + boff + n * 2048 + k * 1024); } while (0)
#define MMA(ai, bj, At_, Bt_) do { __builtin_amdgcn_s_setprio(1); \
    _Pragma("unroll") for (int m = 0; m < 4; ++m) _Pragma("unroll") for (int n = 0; n < 2; ++n) _Pragma("unroll") for (int k = 0; k < 2; ++k) \
      acc[ai][bj][m][n] = MFMA16(Bt_[n][k], At_[m][k], acc[ai][bj][m][n]); \
    __builtin_amdgcn_s_setprio(0); } while (0)
#define WAIT_V(n) asm volatile("s_waitcnt vmcnt(" #n ")" ::: "memory")
#define WAIT_L(n) asm volatile("s_waitcnt lgkmcnt(" #n ")" ::: "memory")
#define BAR __builtin_amdgcn_s_barrier()
#define SCHED __builtin_amdgcn_sched_barrier(0)
  const int brow = pm * BM, bcol = pn * BM;
  const char* cA = (const char*)d.A + (size_t)brow * lda * 2;
  const char* cB = (const char*)d.Bt + (size_t)bcol * ldb * 2;
  f32x4 acc[2][2][4][2];
#pragma unroll
  for (int a = 0; a < 2; ++a)
#pragma unroll
    for (int b = 0; b < 2; ++b)
#pragma unroll
      for (int m = 0; m < 4; ++m)
#pragma unroll
        for (int n = 0; n < 2; ++n) acc[a][b][m][n] = (f32x4){0.f, 0.f, 0.f, 0.f};
  bf16x8 At[4][2], B0[2][2], B1[2][2];
  const int nt = d.K / BK;
  if (!staged) {
    STAGE(SB(0, 0), cB, voffB); STAGE(SA(0, 0), cA, voffA); STAGE(SB(0, 1), cB + hstepB, voffB); STAGE(SA(0, 1), cA + hstepA, voffA);
    if (wr == 1) BAR;
    WAIT_V(4); BAR;
    STAGE(SB(1, 0), cB + kstep, voffB); STAGE(SA(1, 0), cA + kstep, voffA); STAGE(SB(1, 1), cB + hstepB + kstep, voffB);
    WAIT_V(6); BAR;
  } else {
    if (wr == 1) BAR;
    BAR; BAR;
  }
  for (int t = 0; t < nt - 2; t += 2) {
    const char* a1 = cA + (size_t)(t + 1) * kstep;
    const char* a2 = cA + (size_t)(t + 2) * kstep; const char* b2 = cB + (size_t)(t + 2) * kstep;
    const char* a3 = a2 + kstep; const char* b3 = b2 + kstep;
    LDB(B0, 0, 0); SCHED; LDA(At, 0, 0); STAGE(SA(1, 1), a1 + hstepA, voffA);
    WAIT_L(8); BAR; WAIT_L(0); MMA(0, 0, At, B0); BAR; SCHED;
    LDB(B1, 0, 1); STAGE(SB(0, 0), b2, voffB);
    BAR; WAIT_L(0); MMA(0, 1, At, B1); BAR;
    LDA(At, 0, 1); STAGE(SA(0, 0), a2, voffA);
    BAR; WAIT_L(0); MMA(1, 0, At, B0); BAR; SCHED;
    STAGE(SB(0, 1), b2 + hstepB, voffB);
    WAIT_V(6); BAR; MMA(1, 1, At, B1); BAR;
    LDB(B0, 1, 0); SCHED; LDA(At, 1, 0); STAGE(SA(0, 1), a2 + hstepA, voffA);
    WAIT_L(8); BAR; WAIT_L(0); MMA(0, 0, At, B0); BAR; SCHED;
    LDB(B1, 1, 1); STAGE(SB(1, 0), b3, voffB);
    BAR; WAIT_L(0); MMA(0, 1, At, B1); BAR;
    LDA(At, 1, 1); STAGE(SA(1, 0), a3, voffA);
    BAR; WAIT_L(0); MMA(1, 0, At, B0); BAR; SCHED;
    STAGE(SB(1, 1), b3 + hstepB, voffB);
    WAIT_V(6); BAR; MMA(1, 1, At, B1); BAR;
  }
  { LDB(B0, 0, 0); LDA(At, 0, 0); STAGE(SA(1, 1), cA + (size_t)(nt - 1) * kstep + hstepA, voffA);
    BAR; WAIT_L(0); MMA(0, 0, At, B0); BAR;
    LDB(B1, 0, 1); BAR; WAIT_L(0); MMA(0, 1, At, B1); BAR;
    LDA(At, 0, 1); WAIT_V(4); BAR; WAIT_L(0); MMA(1, 0, At, B0); MMA(1, 1, At, B1); BAR; }
  { LDB(B0, 1, 0); LDA(At, 1, 0); WAIT_V(2); BAR; WAIT_L(0); MMA(0, 0, At, B0); BAR;
    LDB(B1, 1, 1); WAIT_V(0); BAR; WAIT_L(0); MMA(0, 1, At, B1); BAR;
    LDA(At, 1, 1); BAR; WAIT_L(0); MMA(1, 0, At, B0); MMA(1, 1, At, B1); BAR; }
  if (wr == 0) BAR;
  if (has_next) {
    const char* nA = (const char*)d.A + (size_t)npm * BM * lda * 2;
    const char* nB = (const char*)d.Bt + (size_t)npn * BM * ldb * 2;
    STAGE(SB(0, 0), nB, voffB); STAGE(SA(0, 0), nA, voffA); STAGE(SB(0, 1), nB + hstepB, voffB); STAGE(SA(0, 1), nA + hstepA, voffA);
    STAGE(SB(1, 0), nB + kstep, voffB); STAGE(SA(1, 0), nA + kstep, voffA); STAGE(SB(1, 1), nB + hstepB + kstep, voffB);
  }
  u32x4v_t gpre[2]; f32x4 tpre[2][2];
  auto ld_group = [&](int ai_, int m_) __attribute__((always_inline)) {
    const int row_ = brow + ai_ * HALF + wr * 64 + m_ * 16 + fr;
#pragma unroll
    for (int bj = 0; bj < 2; ++bj) {
      const int col_ = bcol + bj * HALF + wc * 32 + fq * 8;
      gpre[bj] = *(const u32x4v_t*)(d.gate + (size_t)row_ * NPROJ + col_);
      if (MODE == 3) { const float* mp_ = d.aux + (size_t)row_ * DM + col_; tpre[bj][0] = *(const f32x4*)mp_; tpre[bj][1] = *(const f32x4*)(mp_ + 4); }
    }
  };
  if (MODE == 2 || MODE == 3) ld_group(0, 0);
#pragma unroll
  for (int ai = 0; ai < 2; ++ai)
#pragma unroll
    for (int m = 0; m < 4; ++m) {
      const int row = brow + ai * HALF + wr * 64 + m * 16 + fr;
      u32x4v_t gcur[2]; f32x4 tcur[2][2];
      if (MODE == 2 || MODE == 3) {
        gcur[0] = gpre[0]; gcur[1] = gpre[1];
        if (MODE == 3) { tcur[0][0] = tpre[0][0]; tcur[0][1] = tpre[0][1]; tcur[1][0] = tpre[1][0]; tcur[1][1] = tpre[1][1]; }
        if (!(ai == 1 && m == 3)) ld_group(m == 3 ? ai + 1 : ai, m == 3 ? 0 : m + 1);
      }
      const int colb = bcol + wc * 32 + fq * 4;
      float ssq = 0.f;
#pragma unroll
      for (int bj = 0; bj < 2; ++bj) {
        const int col = bcol + bj * HALF + wc * 32 + fq * 8;
        const f32x4 v0 = acc[ai][bj][m][0], v1 = acc[ai][bj][m][1];
        if (MODE == 0) {
          u32x4v_t pk; pk[0] = pack2(v0[0], v0[1]); pk[1] = pack2(v0[2], v0[3]); pk[2] = pack2(v1[0], v1[1]); pk[3] = pack2(v1[2], v1[3]);
          *(u32x4v_t*)((bf16_t*)d.O + (size_t)row * d.ldo + col) = pk;
          if (d.aux != nullptr && col >= 10240) { *(f32x4*)(d.aux + (size_t)row * 512 + (col - 10240)) = v0; *(f32x4*)(d.aux + (size_t)row * 512 + (col - 10240) + 4) = v1; }
        } else if (MODE == 4) {
          u32x4v_t pk; pk[0] = pack2(v0[0], v0[1]); pk[1] = pack2(v0[2], v0[3]); pk[2] = pack2(v1[0], v1[1]); pk[3] = pack2(v1[2], v1[3]);
          *(u32x4v_t*)((bf16_t*)d.O + (size_t)row * d.ldo + col) = pk;
        } else if (MODE == 1) {
          u32x4v_t pk; pk[0] = pack2(v0[0], v0[1]); pk[1] = pack2(v0[2], v0[3]); pk[2] = pack2(v1[0], v1[1]); pk[3] = pack2(v1[2], v1[3]);
          *(u32x4v_t*)((bf16_t*)d.O + (size_t)row * d.ldo + col) = pk;
          ssq += (v0[0] * v0[0] + v0[1] * v0[1] + v0[2] * v0[2] + v0[3] * v0[3]) + (v1[0] * v1[0] + v1[1] * v1[1] + v1[2] * v1[2] + v1[3] * v1[3]);
        } else {
          const u32x4v_t g = gcur[bj];
          f32x4 s0, s1;
          s0[0] = sigmoidf_(lo2f(g[0])) * v0[0]; s0[1] = sigmoidf_(hi2f(g[0])) * v0[1]; s0[2] = sigmoidf_(lo2f(g[1])) * v0[2]; s0[3] = sigmoidf_(hi2f(g[1])) * v0[3];
          s1[0] = sigmoidf_(lo2f(g[2])) * v1[0]; s1[1] = sigmoidf_(hi2f(g[2])) * v1[1]; s1[2] = sigmoidf_(lo2f(g[3])) * v1[2]; s1[3] = sigmoidf_(hi2f(g[3])) * v1[3];
          float* mp = d.aux + (size_t)row * DM + col;
          if (MODE == 2) { *(f32x4*)mp = s0; *(f32x4*)(mp + 4) = s1; }
          else {
            const f32x4 t0 = tcur[bj][0], t1 = tcur[bj][1];
            u32x4v_t pk; pk[0] = pack2(t0[0] + s0[0], t0[1] + s0[1]); pk[1] = pack2(t0[2] + s0[2], t0[3] + s0[3]); pk[2] = pack2(t1[0] + s1[0], t1[1] + s1[1]); pk[3] = pack2(t1[2] + s1[2], t1[3] + s1[3]);
            *(u32x4v_t*)((bf16_t*)d.O + (size_t)row * d.ldo + col) = pk;
          }
        }
      }
      if (MODE == 1) {
        ssq += __shfl_xor(ssq, 16); ssq += __shfl_xor(ssq, 32);
        if (fq == 0) atomicAdd(d.ss + row, ssq);
      }
    }
  asm volatile("s_waitcnt vmcnt(0)" ::: "memory");
  __syncthreads();
}

template <int MODE>
DEVI void gemm_phase(const GD d, char* shm) {
  const int G = gridDim.x;
  const int c = (blockIdx.x + G - d.boff) % G;
  lds_u8* lds = (lds_u8*)shm;
  int pm, pn, npm = 0, npn = 0;
  bool have = tile_of((long)c, d.nM, d.nN, pm, pn), staged = false;
  for (int i = 0; have; ++i) {
    const bool has_next = tile_of((long)(i + 1) * G + c, d.nM, d.nN, npm, npn);
    gemm_tile<MODE>(d, pm, pn, lds, staged, has_next, npm, npn);
    staged = has_next; have = has_next; pm = npm; pn = npn;
  }
}

DEVI int perm32(int rho) { const int n = rho >> 4, i = rho & 15; return 8 * (i >> 2) + 4 * n + (i & 3); }

DEVI int srccol(int n, int mode) {
  if (mode == 0) return n;
  if (n < 3072) return n;
  if (n < 6144) return n + 8;
  if (n < 10240) return n + 296;
  if (n < 10528) return n - 4088;
  if (n < 10536) return n - 7456;
  return -1;
}
DEVI void conv_weight(const float* __restrict__ W, int ldw, int K, int N, bf16_t* __restrict__ Wt, int mode, int gw, int GW, int lane, const bool nts = false, const bool perm = false) {
  const int nkb = K / 64, ntask = (N / 64) * nkb;
  for (int t = gw; t < ntask; t += GW) {
    const int nb = t / nkb, kb = t % nkb;
    const int n = nb * 64 + lane; const int ns = perm ? ((n & ~31) + perm32(n & 31)) : n; const int sc = srccol(ns, mode);
    const float* src = W + (size_t)(kb * 64) * ldw + (sc < 0 ? 0 : sc);
    bf16_t* dst = Wt + (size_t)n * K + kb * 64;
#pragma unroll
    for (int j8 = 0; j8 < 8; ++j8) {
      float f[8];
#pragma unroll
      for (int j = 0; j < 8; ++j) f[j] = __builtin_nontemporal_load(src + (size_t)(j8 * 8 + j) * ldw);
      if (sc < 0) {
#pragma unroll
        for (int j = 0; j < 8; ++j) f[j] = 0.f;
      }
      u32x4v_t o; o[0] = pack2(f[0], f[1]); o[1] = pack2(f[2], f[3]); o[2] = pack2(f[4], f[5]); o[3] = pack2(f[6], f[7]);
      if (nts) __builtin_nontemporal_store(o, (u32x4v_t*)(dst + j8 * 8)); else *(u32x4v_t*)(dst + j8 * 8) = o;
    }
  }
}
DEVI void conv_weight_lds(const float* __restrict__ W, int ldw, int K, int N, bf16_t* __restrict__ Wt, int mode, int gw, int GW, int lane, float* scr, const bool nts) {
  const int nkb = K / 64, ntask = (N / 64) * nkb;
  for (int t = gw; t < ntask; t += GW) {
    const int nb = t / nkb, kb = t % nkb, n0 = nb * 64;
    const int sc = srccol(n0 + lane, mode);
    const float* src = W + (size_t)(kb * 64) * ldw + (sc < 0 ? 0 : sc);
#pragma unroll 16
    for (int j = 0; j < 64; ++j) { const float f = __builtin_nontemporal_load(src + (size_t)j * ldw); scr[j * 65 + lane] = (sc < 0) ? 0.f : f; }
    const int c = lane & 7, rsub = lane >> 3;
#pragma unroll
    for (int jj = 0; jj < 8; ++jj) {
      const int r = rsub + 8 * jj, cs = (r & ~31) + perm32(r & 31);
      const float* sp = scr + (8 * c) * 65 + cs;
      u32x4v_t o; o[0] = pack2(sp[0], sp[65]); o[1] = pack2(sp[2 * 65], sp[3 * 65]); o[2] = pack2(sp[4 * 65], sp[5 * 65]); o[3] = pack2(sp[6 * 65], sp[7 * 65]);
      bf16_t* dp = Wt + (size_t)(n0 + r) * K + kb * 64 + 8 * c;
      if (nts) __builtin_nontemporal_store(o, (u32x4v_t*)dp); else *(u32x4v_t*)dp = o;
    }
  }
}
DEVI void conv_task64(const float* __restrict__ W, int ldw, int K, bf16_t* __restrict__ Wt, int t, int lane) {
  const int nkb = K / 64, nb = t / nkb, kb = t % nkb, n = nb * 64 + lane;
  const float* src = W + (size_t)(kb * 64) * ldw + ((n & ~31) + perm32(n & 31));
  bf16_t* dst = Wt + (size_t)n * K + kb * 64;
#pragma unroll
  for (int j8 = 0; j8 < 8; ++j8) {
    float f[8];
#pragma unroll
    for (int j = 0; j < 8; ++j) f[j] = __builtin_nontemporal_load(src + (size_t)(j8 * 8 + j) * ldw);
    uint4 o; o.x = pack2(f[0], f[1]); o.y = pack2(f[2], f[3]); o.z = pack2(f[4], f[5]); o.w = pack2(f[6], f[7]);
    *(uint4*)(dst + j8 * 8) = o;
  }
}
DEVI void late_conv_task(const Params& p, int t, int lane) {
  char* ws = p.ws;
  if (t < 512) conv_task64(p.in[18], 2048, 1024, (bf16_t*)(ws + O_WA), t, lane);
  else if (t < 1024) conv_task64(p.in[19], 2048, 1024, (bf16_t*)(ws + O_WB), t - 512, lane);
  else if (t < 2048) conv_task64(p.in[20], 2048, 2048, (bf16_t*)(ws + O_WOUT), t - 1024, lane);
  else if (t < 2304) conv_task64(p.in[24], 512, 2048, (bf16_t*)(ws + O_WQ), t - 2048, lane);
  else if (t < 2560) conv_task64(p.in[26], 2048, 512, (bf16_t*)(ws + O_WO), t - 2304, lane);
}
DEVI void rms_row_bf16(const float* __restrict__ xr, const float* __restrict__ g, bf16_t* __restrict__ o, int lane) {
  f32x4 v[8]; float s = 0.f;
#pragma unroll
  for (int i = 0; i < 8; ++i) { v[i] = __builtin_nontemporal_load((const f32x4*)(xr + 4 * (lane + 64 * i))); s += v[i][0] * v[i][0] + v[i][1] * v[i][1] + v[i][2] * v[i][2] + v[i][3] * v[i][3]; }
  const float r = rsqrtf(wave_sum(s) * (1.f / 2048.f) + 1e-6f);
#pragma unroll
  for (int i = 0; i < 8; ++i) {
    const f32x4 gg = *(const f32x4*)(g + 4 * (lane + 64 * i));
    uint2 pk; pk.x = pack2(v[i][0] * r * gg[0], v[i][1] * r * gg[1]); pk.y = pack2(v[i][2] * r * gg[2], v[i][3] * r * gg[3]);
    *(uint2*)(o + 4 * (lane + 64 * i)) = pk;
  }
}
template <bool XI16, bool XO16>
DEVI void resid_row(const void* __restrict__ xi_, const bf16_t* __restrict__ y, float ssv, const float* __restrict__ gpost, void* __restrict__ xo_,
                    const float* __restrict__ gpre, bf16_t* __restrict__ ho, int lane) {
  const float r1 = rsqrtf(ssv * (1.f / 2048.f) + 1e-6f);
  f32x4 v[8]; float s = 0.f;
#pragma unroll
  for (int i = 0; i < 8; ++i) {
    const int c = 4 * (lane + 64 * i);
    f32x4 a; const f32x4 gg = *(const f32x4*)(gpost + c);
    if (XI16) { const u32x2_t xb = __builtin_nontemporal_load((const u32x2_t*)((const bf16_t*)xi_ + c)); a[0] = lo2f(xb[0]); a[1] = hi2f(xb[0]); a[2] = lo2f(xb[1]); a[3] = hi2f(xb[1]); }
    else a = __builtin_nontemporal_load((const f32x4*)((const float*)xi_ + c));
    const uint2 yb = *(const uint2*)(y + c);
    f32x4 b; b[0] = lo2f(yb.x); b[1] = hi2f(yb.x); b[2] = lo2f(yb.y); b[3] = hi2f(yb.y);
#pragma unroll
    for (int j = 0; j < 4; ++j) v[i][j] = a[j] + b[j] * r1 * gg[j];
    s += v[i][0] * v[i][0] + v[i][1] * v[i][1] + v[i][2] * v[i][2] + v[i][3] * v[i][3];
  }
#pragma unroll
  for (int i = 0; i < 8; ++i) {
    const int c = 4 * (lane + 64 * i);
    if (XO16) { u32x2_t ob; ob[0] = pack2(v[i][0], v[i][1]); ob[1] = pack2(v[i][2], v[i][3]); __builtin_nontemporal_store(ob, (u32x2_t*)((bf16_t*)xo_ + c)); }
    else __builtin_nontemporal_store(v[i], (f32x4*)((float*)xo_ + c));
  }
  if (ho != nullptr) {
    const float r = rsqrtf(wave_sum(s) * (1.f / 2048.f) + 1e-6f);
#pragma unroll
    for (int i = 0; i < 8; ++i) {
      const int c = 4 * (lane + 64 * i);
      const f32x4 gg = *(const f32x4*)(gpre + c);
      uint2 pk; pk.x = pack2(v[i][0] * r * gg[0], v[i][1] * r * gg[1]); pk.y = pack2(v[i][2] * r * gg[2], v[i][3] * r * gg[3]);
      *(uint2*)(ho + c) = pk;
    }
  }
}

DEVI void rwkv_prep_tile(const Params& p, int tile, char* shm) {
  const int tid = fresh_tid(), wid = tid >> 6, lane = tid & 63, fr = lane & 15, fq = lane >> 4;
  char* ws = p.ws;
  const float* tail = (const float*)(ws + O_TAIL);
  const bf16_t* proj = (const bf16_t*)(ws + O_PROJ);
  const float* mu = p.in[7];
  const int t0 = tile * 32;
  bf16_t* actW = (bf16_t*)shm;
  bf16_t* actA = actW + 32 * 72;
  bf16_t* actG = actA + 32 * 72;
  bf16_t* aS   = actG + 32 * 168;
  bf16x8 bfa[2][8];
  {
    const bf16_t* aupT_ = (const bf16_t*)(ws + O_WLR) + 1024 * 64;
#pragma unroll
    for (int ks = 0; ks < 2; ++ks)
#pragma unroll
      for (int n = 0; n < 8; ++n) bfa[ks][n] = *(const bf16x8*)(aupT_ + (size_t)(wid * 128 + n * 16 + fr) * 64 + ks * 32 + fq * 8);
  }
  for (int e = tid; e < 32 * 288; e += 512) {
    const int tt = e / 288, c = e % 288, t = t0 + tt;
    const float pc = tail[(size_t)t * 512 + c];
    const float pp = ((t % SEQ) > 0) ? tail[(size_t)(t - 1) * 512 + c] : 0.f;
    const float v = pc + (pp - pc) * mu[3072 + c];
    if (c < 64) actW[tt * 72 + c] = f2bf(tanhf(v));
    else if (c < 128) actA[tt * 72 + (c - 64)] = f2bf(v);
    else actG[tt * 168 + (c - 128)] = f2bf(sigmoidf_(v));
  }
  __syncthreads();
  const bf16_t* wupT = (const bf16_t*)(ws + O_WLR);
  const bf16_t* aupT = wupT + 1024 * 64;
  const bf16_t* gupT = aupT + 1024 * 64;
  const int ch0 = wid * 128;
  {
    f32x4 acc[2][8];
#pragma unroll
    for (int m = 0; m < 2; ++m)
#pragma unroll
      for (int n = 0; n < 8; ++n) acc[m][n] = (f32x4){0.f, 0.f, 0.f, 0.f};
#pragma unroll
    for (int ks = 0; ks < 2; ++ks) {
      bf16x8 af[2];
#pragma unroll
      for (int m = 0; m < 2; ++m) af[m] = *(const bf16x8*)(actA + (m * 16 + fr) * 72 + ks * 32 + fq * 8);
#pragma unroll
      for (int n = 0; n < 8; ++n) {
#pragma unroll
        for (int m = 0; m < 2; ++m) acc[m][n] = MFMA16(af[m], bfa[ks][n], acc[m][n]);
      }
    }
    const float* a0 = p.in[10];
#pragma unroll
    for (int n = 0; n < 8; ++n) {
      const int ch = ch0 + n * 16 + fr; const float a0v = a0[ch];
#pragma unroll
      for (int m = 0; m < 2; ++m)
#pragma unroll
        for (int j = 0; j < 4; ++j) aS[(m * 16 + fq * 4 + j) * 1032 + ch] = f2bf(sigmoidf_(a0v + acc[m][n][j]));
    }
  }
  {
    f32x4 acc[2][8];
#pragma unroll
    for (int m = 0; m < 2; ++m)
#pragma unroll
      for (int n = 0; n < 8; ++n) acc[m][n] = (f32x4){0.f, 0.f, 0.f, 0.f};
#pragma unroll
    for (int ks = 0; ks < 2; ++ks) {
      bf16x8 af[2];
#pragma unroll
      for (int m = 0; m < 2; ++m) af[m] = *(const bf16x8*)(actW + (m * 16 + fr) * 72 + ks * 32 + fq * 8);
#pragma unroll
      for (int n = 0; n < 8; ++n) {
        const bf16x8 bfr = *(const bf16x8*)(wupT + (size_t)(ch0 + (n >> 1) * 32 + perm32((n & 1) * 16 + fr)) * 64 + ks * 32 + fq * 8);
#pragma unroll
        for (int m = 0; m < 2; ++m) acc[m][n] = MFMA16(bfr, af[m], acc[m][n]);
      }
    }
    const float* w0 = p.in[8];
    float* RW = (float*)(ws + O_RW);
#pragma unroll
    for (int gq = 0; gq < 4; ++gq) {
      const int chb = ch0 + gq * 32 + fq * 8;
      const f32x4 w0a = *(const f32x4*)(w0 + chb), w0b = *(const f32x4*)(w0 + chb + 4);
#pragma unroll
      for (int m = 0; m < 2; ++m) {
        f32x4 oa, ob;
#pragma unroll
        for (int j = 0; j < 4; ++j) {
          const float za = -(w0a[j] + acc[m][2 * gq][j]), zb = -(w0b[j] + acc[m][2 * gq + 1][j]);
          const float spa = fmaxf(za, 0.f) + log1pf(__expf(-fabsf(za))), spb = fmaxf(zb, 0.f) + log1pf(__expf(-fabsf(zb)));
          oa[j] = __expf(-__expf(-spa - 0.5f)); ob[j] = __expf(-__expf(-spb - 0.5f));
        }
        float* dp = RW + (size_t)(t0 + m * 16 + fr) * 1024 + chb;
        *(f32x4*)dp = oa; *(f32x4*)(dp + 4) = ob;
      }
    }
  }
  {
    f32x4 acc[2][8];
#pragma unroll
    for (int m = 0; m < 2; ++m)
#pragma unroll
      for (int n = 0; n < 8; ++n) acc[m][n] = (f32x4){0.f, 0.f, 0.f, 0.f};
#pragma unroll
    for (int ks = 0; ks < 5; ++ks) {
      bf16x8 af[2];
#pragma unroll
      for (int m = 0; m < 2; ++m) af[m] = *(const bf16x8*)(actG + (m * 16 + fr) * 168 + ks * 32 + fq * 8);
#pragma unroll
      for (int n = 0; n < 8; ++n) {
        const bf16x8 bfr = *(const bf16x8*)(gupT + (size_t)(ch0 + (n >> 1) * 32 + perm32((n & 1) * 16 + fr)) * 160 + ks * 32 + fq * 8);
#pragma unroll
        for (int m = 0; m < 2; ++m) acc[m][n] = MFMA16(bfr, af[m], acc[m][n]);
      }
    }
    bf16_t* RG = (bf16_t*)(ws + O_RG);
#pragma unroll
    for (int gq = 0; gq < 4; ++gq)
#pragma unroll
      for (int m = 0; m < 2; ++m) {
        const f32x4 v0 = acc[m][2 * gq], v1 = acc[m][2 * gq + 1];
        u32x4v_t pk; pk[0] = pack2(v0[0], v0[1]); pk[1] = pack2(v0[2], v0[3]); pk[2] = pack2(v1[0], v1[1]); pk[3] = pack2(v1[2], v1[3]);
        *(u32x4v_t*)(RG + (size_t)(t0 + m * 16 + fr) * 1024 + ch0 + gq * 32 + fq * 8) = pk;
      }
  }
  __syncthreads();
  {
    bf16_t* RR = (bf16_t*)(ws + O_RR); bf16_t* RK = (bf16_t*)(ws + O_RK); bf16_t* RV = (bf16_t*)(ws + O_RV);
    bf16_t* RKK = (bf16_t*)(ws + O_RKK); bf16_t* RKA = (bf16_t*)(ws + O_RKA);
    const float* k_k = p.in[13]; const float* k_a = p.in[14];
#pragma unroll 1
    for (int hsel = 0; hsel < 2; ++hsel) {
      const int hh = wid + 8 * hsel, ch = hh * 64 + lane;
      const float mur = mu[ch], muk = mu[1024 + ch], muv = mu[2048 + ch], kkc = k_k[ch], kac = k_a[ch];
      const bf16_t* pc0 = proj + (size_t)t0 * NPROJ + 3072 + ch;
      float rp = 0.f, kp = 0.f, vp = 0.f;
      if ((t0 % SEQ) > 0) { rp = bf2f(*(pc0 - NPROJ)); kp = bf2f(*(pc0 - NPROJ + 1024)); vp = bf2f(*(pc0 - NPROJ + 2048)); }
#pragma unroll 1
      for (int tb = 0; tb < 32; tb += 4) {
        float rc[4], kc[4], vc[4], av[4];
#pragma unroll
        for (int j = 0; j < 4; ++j) {
          const bf16_t* pc = pc0 + (size_t)(tb + j) * NPROJ;
          rc[j] = bf2f(pc[0]); kc[j] = bf2f(pc[1024]); vc[j] = bf2f(pc[2048]); av[j] = bf2f(aS[(tb + j) * 1032 + ch]);
        }
#pragma unroll
        for (int j = 0; j < 4; ++j) {
          const float r = rc[j] + (rp - rc[j]) * mur, k = kc[j] + (kp - kc[j]) * muk, v = vc[j] + (vp - vc[j]) * muv, a = av[j];
          float kk = k * kkc;
          const float nrm = sqrtf(wave_sum_fast(kk * kk));
          kk = kk / fmaxf(nrm, 1e-12f);
          const float k2 = k * (1.f + (a - 1.f) * kac);
          const size_t o = (size_t)(t0 + tb + j) * 1024 + ch;
          RR[o] = f2bf(r); RK[o] = f2bf(k2); RV[o] = f2bf(v); RKK[o] = f2bf(kk); RKA[o] = f2bf(kk * a);
          rp = rc[j]; kp = kc[j]; vp = vc[j];
        }
      }
    }
  }
  __syncthreads();
}

DEVI float softcap15(float x) { const float z = x * (1.f / 15.f); return 15.f * (1.f - 2.f / (1.f + expf(2.f * z))); }

DEVI int invperm32(int d) { return 16 * ((d >> 2) & 1) + 4 * (d >> 3) + (d & 3); }
DEVI void stage_T64(const bf16_t* __restrict__ src, int ncol, bf16_t* dst, const float* sc, int tid, const bool perm = false) {
  for (int e = tid; e < 64 * ncol / 8; e += 512) {
    const int s = e & 63, cg8 = e >> 6;
    const uint4 v = *(const uint4*)(src + (size_t)s * NPROJ + cg8 * 8);
    const float f = sc ? sc[s] : 1.f;
    bf16_t* dp = dst + (perm ? ((cg8 >> 2) * 32 + (cg8 & 3) * 4) : (cg8 * 8)) * 72 + s;
    const int hi = perm ? 16 * 72 : 4 * 72;
    dp[0 * 72] = f2bf(lo2f(v.x) * f); dp[1 * 72] = f2bf(hi2f(v.x) * f); dp[2 * 72] = f2bf(lo2f(v.y) * f); dp[3 * 72] = f2bf(hi2f(v.y) * f);
    dp[hi + 0 * 72] = f2bf(lo2f(v.z) * f); dp[hi + 1 * 72] = f2bf(hi2f(v.z) * f); dp[hi + 2 * 72] = f2bf(lo2f(v.w) * f); dp[hi + 3 * 72] = f2bf(hi2f(v.w) * f);
  }
}

DEVI void mlstm_A(const Params& p, int task, char* shm) {
  const int tid = fresh_tid(), wid = tid >> 6, lane = tid & 63, fr = lane & 15, fq = lane >> 4;
  char* ws = p.ws;
  const int bh = task >> 6, c = task & 63, b = bh >> 2, h = bh & 3, t0 = b * SEQ + c * 64;
  const float* tail = (const float*)(ws + O_TAIL);
  const bf16_t* proj = (const bf16_t*)(ws + O_PROJ);
  bf16_t* vT = (bf16_t*)shm;
  bf16_t* kT = vT + 256 * 72;
  float* wsS = (float*)(kT + 128 * 72);
  uint4 vreg[4];
#pragma unroll
  for (int i = 0; i < 4; ++i) { const int e = tid + 512 * i; vreg[i] = *(const uint4*)(proj + (size_t)(t0 + (e & 63)) * NPROJ + 1024 + h * 256 + (e >> 6) * 8); }
  stage_T64(proj + (size_t)t0 * NPROJ + 512 + h * 128, 128, kT, nullptr, tid, true);
  if (wid == 0) {
    const int t = t0 + lane;
    const float ipre = tail[(size_t)t * 512 + 288 + h] + p.in[4][h];
    const float fpre = tail[(size_t)t * 512 + 292 + h] + p.in[5][h];
    const float ig = softcap15(ipre);
    const float fs = softcap15(fpre);
    const float logf = -(fmaxf(-fs, 0.f) + log1pf(expf(-fabsf(fs))));
    float bc = logf;
#pragma unroll
    for (int o = 1; o < 64; o <<= 1) { const float u = __shfl_up(bc, o); if (lane >= o) bc += u; }
    const float bL = __shfl(bc, 63);
    const float gs = bL - bc + ig;
    const float gm = wave_max(gs);
    wsS[lane] = expf(gs - gm);
    ((float*)(ws + O_BCUM))[(size_t)t * 4 + h] = bc;
    ((float*)(ws + O_IG))[(size_t)t * 4 + h] = ig;
    if (lane == 0) { ((float*)(ws + O_GMAX))[task] = gm; ((float*)(ws + O_BL))[task] = bL; }
  }
  __syncthreads();
#pragma unroll
  for (int i = 0; i < 4; ++i) {
    const int e = tid + 512 * i, s_ = e & 63, cg8 = e >> 6; const uint4 v = vreg[i]; const float f = wsS[s_];
    bf16_t* dp = vT + (cg8 * 8) * 72 + s_;
    dp[0 * 72] = f2bf(lo2f(v.x) * f); dp[1 * 72] = f2bf(hi2f(v.x) * f); dp[2 * 72] = f2bf(lo2f(v.y) * f); dp[3 * 72] = f2bf(hi2f(v.y) * f);
    dp[4 * 72] = f2bf(lo2f(v.z) * f); dp[5 * 72] = f2bf(hi2f(v.z) * f); dp[6 * 72] = f2bf(lo2f(v.w) * f); dp[7 * 72] = f2bf(hi2f(v.w) * f);
  }
  __syncthreads();
  {
    f32x4 acc[2][8];
#pragma unroll
    for (int m = 0; m < 2; ++m)
#pragma unroll
      for (int n = 0; n < 8; ++n) acc[m][n] = (f32x4){0.f, 0.f, 0.f, 0.f};
#pragma unroll
    for (int ks = 0; ks < 2; ++ks) {
      bf16x8 af[2];
#pragma unroll
      for (int m = 0; m < 2; ++m) af[m] = *(const bf16x8*)(vT + (wid * 32 + m * 16 + fr) * 72 + ks * 32 + fq * 8);
#pragma unroll
      for (int n = 0; n < 8; ++n) {
        const bf16x8 bfr = *(const bf16x8*)(kT + (n * 16 + fr) * 72 + ks * 32 + fq * 8);
#pragma unroll
        for (int m = 0; m < 2; ++m) acc[m][n] = MFMA16(bfr, af[m], acc[m][n]);
      }
    }
    bf16_t* dC = (bf16_t*)(ws + O_DC) + (size_t)task * 32768;
#pragma unroll
    for (int m = 0; m < 2; ++m)
#pragma unroll
      for (int gq = 0; gq < 4; ++gq) {
        bf16_t* dp = dC + (wid * 32 + m * 16 + fr) * 128 + gq * 32 + fq * 8;
        const f32x4 v0 = acc[m][2 * gq], v1 = acc[m][2 * gq + 1];
        u32x4v_t pk; pk[0] = pack2(v0[0], v0[1]); pk[1] = pack2(v0[2], v0[3]); pk[2] = pack2(v1[0], v1[1]); pk[3] = pack2(v1[2], v1[3]);
        __builtin_nontemporal_store(pk, (u32x4v_t*)dp);
      }
  }
  if (tid < 128) {
    float s = 0.f;
    const int krow = (tid & ~31) + invperm32(tid & 31);
    for (int i = 0; i < 64; ++i) s += wsS[i] * bf2f(kT[krow * 72 + i]);
    ((float*)(ws + O_DN))[(size_t)task * 128 + tid] = s;
  }
  __syncthreads();
}

DEVI void mlstm_scan(const Params& p, int mt, int MT) {
  char* ws = p.ws;
  const float* bLb = (const float*)(ws + O_BL); const float* gmb = (const float*)(ws + O_GMAX);
  for (int g = mt; g < 65536 + 1024; g += MT) {
    if (g < 65536) {
      const int bh = g >> 13, e4 = g & 8191;
      float m = 0.f; f32x4 C = (f32x4){0.f, 0.f, 0.f, 0.f};
      for (int c = 0; c < 64; ++c) {
        const int idx = bh * 64 + c;
        uint2 pk; pk.x = pack2(C[0], C[1]); pk.y = pack2(C[2], C[3]);
        *(uint2*)((bf16_t*)(ws + O_CST) + (size_t)idx * 32768 + e4 * 4) = pk;
        if (e4 == 0) ((float*)(ws + O_MST))[idx] = m;
        const float bL = bLb[idx], gm = gmb[idx];
        const float mn = fmaxf(bL + m, gm), cw = expf(bL + m - mn), lw = expf(gm - mn);
        const u32x2_t db = *(const u32x2_t*)((const bf16_t*)(ws + O_DC) + (size_t)idx * 32768 + e4 * 4);
        f32x4 dd; dd[0] = lo2f(db[0]); dd[1] = hi2f(db[0]); dd[2] = lo2f(db[1]); dd[3] = hi2f(db[1]);
        C = cw * C + lw * dd; m = mn;
      }
    } else {
      const int q = g - 65536, bh = q >> 7, dk = q & 127;
      float m = 0.f, n = 0.f;
      for (int c = 0; c < 64; ++c) {
        const int idx = bh * 64 + c;
        ((float*)(ws + O_NST))[(size_t)idx * 128 + dk] = n;
        const float bL = bLb[idx], gm = gmb[idx];
        const float mn = fmaxf(bL + m, gm), cw = expf(bL + m - mn), lw = expf(gm - mn);
        n = cw * n + lw * ((const float*)(ws + O_DN))[(size_t)idx * 128 + dk]; m = mn;
      }
    }
  }
}

DEVI void mlstm_D(const Params& p, int task, char* shm) {
  const int tid = fresh_tid(), wid = tid >> 6, lane = tid & 63, fr = lane & 15, fq = lane >> 4;
  char* ws = p.ws;
  const int bh = task >> 6, c = task & 63, b = bh >> 2, h = bh & 3, t0 = b * SEQ + c * 64;
  const bf16_t* proj = (const bf16_t*)(ws + O_PROJ);
  bf16_t* qS = (bf16_t*)shm;
  bf16_t* kS = qS + 64 * 136;
  bf16_t* vT = kS + 64 * 136;
  bf16_t* PS = vT + 256 * 72;
  float* fS = (float*)(PS + 64 * 72);
  float* bS = fS, *igS = fS + 64, *mtS = fS + 128, *wiS = fS + 192, *rdS = fS + 256, *nqS = fS + 320, *hsq = fS + 384, *nsS = fS + 448;
  const float scale = 0.08838834764831845f;
  const float m_s = ((const float*)(ws + O_MST))[task];
  float og[4][4][2];
#pragma unroll
  for (int m = 0; m < 4; ++m)
#pragma unroll
    for (int j = 0; j < 4; ++j)
#pragma unroll
      for (int n = 0; n < 2; ++n) og[m][j][n] = bf2f(proj[(size_t)(t0 + m * 16 + fq * 4 + j) * NPROJ + 2048 + h * 256 + wid * 32 + n * 16 + fr]);
  bf16x8 cfr[4][2];
  {
    const bf16_t* Cst0 = (const bf16_t*)(ws + O_CST) + (size_t)task * 32768;
#pragma unroll
    for (int ks = 0; ks < 4; ++ks)
#pragma unroll
      for (int n = 0; n < 2; ++n) cfr[ks][n] = *(const bf16x8*)(Cst0 + (size_t)(wid * 32 + n * 16 + fr) * 128 + ks * 32 + fq * 8);
  }
  if (tid < 64) { bS[tid] = ((const float*)(ws + O_BCUM))[(size_t)(t0 + tid) * 4 + h]; igS[tid] = ((const float*)(ws + O_IG))[(size_t)(t0 + tid) * 4 + h]; hsq[tid] = 0.f; }
  else if (tid < 192) nsS[tid - 64] = ((const float*)(ws + O_NST))[(size_t)task * 128 + (tid - 64)];
  for (int e = tid; e < 1024; e += 512) {
    const int s = e >> 4, c8 = e & 15;
    *(uint4*)(qS + s * 136 + c8 * 8) = *(const uint4*)(proj + (size_t)(t0 + s) * NPROJ + h * 128 + c8 * 8);
    *(uint4*)(kS + s * 136 + c8 * 8) = *(const uint4*)(proj + (size_t)(t0 + s) * NPROJ + 512 + h * 128 + c8 * 8);
  }
  stage_T64(proj + (size_t)t0 * NPROJ + 1024 + h * 256, 256, vT, nullptr, tid);
  __syncthreads();
  if (tid < 64) {
    float am = -INFINITY;
    for (int s = 0; s <= tid; ++s) am = fmaxf(am, igS[s] - bS[s]);
    const float mt_ = bS[tid] + fmaxf(m_s, am);
    mtS[tid] = mt_; wiS[tid] = expf(bS[tid] + m_s - mt_) * scale;
  } else if (tid < 128) {
    const int t = tid - 64; float s = 0.f;
    for (int i = 0; i < 128; ++i) s += nsS[i] * bf2f(qS[t * 136 + i]);
    nqS[t] = s;
  }
  f32x4 sacc[2];
  const int mt_i = wid >> 1, nt0 = (wid & 1) * 2;
  {
    sacc[0] = (f32x4){0.f, 0.f, 0.f, 0.f}; sacc[1] = sacc[0];
#pragma unroll
    for (int ks = 0; ks < 4; ++ks) {
      const bf16x8 af = *(const bf16x8*)(qS + (mt_i * 16 + fr) * 136 + ks * 32 + fq * 8);
#pragma unroll
      for (int n = 0; n < 2; ++n) {
        const bf16x8 bfr = *(const bf16x8*)(kS + ((nt0 + n) * 16 + fr) * 136 + ks * 32 + fq * 8);
        sacc[n] = MFMA16(af, bfr, sacc[n]);
      }
    }
  }
  __syncthreads();
#pragma unroll
  for (int n = 0; n < 2; ++n) {
    const int s = (nt0 + n) * 16 + fr;
#pragma unroll
    for (int j = 0; j < 4; ++j) {
      const int t = mt_i * 16 + fq * 4 + j;
      float pv = 0.f;
      if (s <= t) pv = sacc[n][j] * scale * expf(bS[t] - bS[s] + igS[s] - mtS[t]);
      PS[t * 72 + s] = f2bf(pv);
    }
  }
  __syncthreads();
  if (tid < 64) {
    float rs = 0.f;
    for (int s = 0; s < 64; ++s) rs += bf2f(PS[tid * 72 + s]);
    const float den = wiS[tid] * nqS[tid] + rs;
    rdS[tid] = 1.f / fmaxf(fabsf(den), expf(-mtS[tid]));
  }
  f32x4 acc[4][2];
#pragma unroll
  for (int m = 0; m < 4; ++m) { acc[m][0] = (f32x4){0.f, 0.f, 0.f, 0.f}; acc[m][1] = acc[m][0]; }
  {
#pragma unroll
    for (int ks = 0; ks < 4; ++ks) {
#pragma unroll
      for (int m = 0; m < 4; ++m) {
        const bf16x8 af = *(const bf16x8*)(qS + (m * 16 + fr) * 136 + ks * 32 + fq * 8);
#pragma unroll
        for (int n = 0; n < 2; ++n) acc[m][n] = MFMA16(af, cfr[ks][n], acc[m][n]);
      }
    }
#pragma unroll
    for (int m = 0; m < 4; ++m)
#pragma unroll
      for (int j = 0; j < 4; ++j) { const float w = wiS[m * 16 + fq * 4 + j]; acc[m][0][j] *= w; acc[m][1][j] *= w; }
#pragma unroll
    for (int ks = 0; ks < 2; ++ks) {
      bf16x8 bfr[2];
#pragma unroll
      for (int n = 0; n < 2; ++n) bfr[n] = *(const bf16x8*)(vT + (wid * 32 + n * 16 + fr) * 72 + ks * 32 + fq * 8);
#pragma unroll
      for (int m = 0; m < 4; ++m) {
        const bf16x8 af = *(const bf16x8*)(PS + (m * 16 + fr) * 72 + ks * 32 + fq * 8);
#pragma unroll
        for (int n = 0; n < 2; ++n) acc[m][n] = MFMA16(af, bfr[n], acc[m][n]);
      }
    }
  }
  __syncthreads();
#pragma unroll
  for (int m = 0; m < 4; ++m)
#pragma unroll
    for (int j = 0; j < 4; ++j) {
      const int t = m * 16 + fq * 4 + j; const float rd = rdS[t];
      acc[m][0][j] *= rd; acc[m][1][j] *= rd;
      float sq = acc[m][0][j] * acc[m][0][j] + acc[m][1][j] * acc[m][1][j];
      sq = sum16(sq);
      if (fr == 0) atomicAdd(&hsq[t], sq);
    }
  __syncthreads();
  {
    const float* hn = p.in[6];
    bf16_t* HA = (bf16_t*)(ws + O_HA);
#pragma unroll
    for (int m = 0; m < 4; ++m)
#pragma unroll
      for (int j = 0; j < 4; ++j) {
        const int t = m * 16 + fq * 4 + j; const float rn = rsqrtf(hsq[t] * (1.f / 256.f) + 1e-6f);
#pragma unroll
        for (int n = 0; n < 2; ++n) {
          const int dv = h * 256 + wid * 32 + n * 16 + fr;
          const float o = og[m][j][n];
          HA[(size_t)(t0 + t) * 1024 + dv] = f2bf(sigmoidf_(o) * acc[m][n][j] * rn * hn[dv]);
        }
      }
  }
  __syncthreads();
}

typedef float f32x2 __attribute__((ext_vector_type(2)));
DEVI float sum32(float x) {
  x = dpp_sum16(x);
  const unsigned a = __float_as_uint(x);
  const auto r = __builtin_amdgcn_permlane16_swap(a, a, false, false);
  return __uint_as_float(r[0]) + __uint_as_float(r[1]);
}
constexpr int SC_T = 32, SC_BUF = 41984;
constexpr int SC_PA = 0, SC_PB = 16384, SC_PC = 32768, SC_PV = 40960, SC_YP = 2 * SC_BUF, SC_YPSZ = 32768;
DEVI void scan_yreduce(const Params& p, const char* shm, int chunk, int q, int b, int h, int rowb) {
  const int s_ = q >> 3, r8 = q & 7;
  const float* yp = (const float*)(shm + SC_YP + (chunk & 1) * SC_YPSZ) + ((s_ * 4 + (r8 >> 1)) * 64 + (r8 & 1) * 32);
  f32x4 acc = (f32x4){0.f, 0.f, 0.f, 0.f};
#pragma unroll
  for (int jj = 0; jj < 8; ++jj) acc += *(const f32x4*)(yp + (((jj + q) & 7) * 4));
  ((float*)(p.ws + O_YS))[((size_t)b * SEQ + (size_t)chunk * SC_T + s_) * 1024 + h * 64 + rowb + r8] = (acc[0] + acc[1]) + (acc[2] + acc[3]);
}
struct ScanE { f32x2 w; unsigned kk, ka, k, r; };
DEVI void scan_ld1(ScanE& e, const char* ws, size_t o) {
  e.w = *(const f32x2*)((const float*)(ws + O_RW) + o); e.kk = *(const unsigned*)((const bf16_t*)(ws + O_RKK) + o); e.ka = *(const unsigned*)((const bf16_t*)(ws + O_RKA) + o);
  e.k = *(const unsigned*)((const bf16_t*)(ws + O_RK) + o); e.r = *(const unsigned*)((const bf16_t*)(ws + O_RR) + o);
}
DEVI void scan_st1(const ScanE& e, char* buf, int lE) {
  f32x4 ta, tb; ta[0] = e.w[0]; ta[1] = e.w[1]; ta[2] = lo2f(e.kk); ta[3] = hi2f(e.kk); tb[0] = lo2f(e.ka); tb[1] = hi2f(e.ka); tb[2] = lo2f(e.k); tb[3] = hi2f(e.k);
  *(f32x4*)(buf + SC_PA + lE * 16) = ta; *(f32x4*)(buf + SC_PB + lE * 16) = tb;
  *(f32x2*)(buf + SC_PC + lE * 8) = (f32x2){lo2f(e.r), hi2f(e.r)};
}
#define SCAN_LD(off) do { if (isH) { scan_ld1(E0, ws, gE + (off)); scan_ld1(E1, ws, gE + (off) + 8192); scan_ld1(E2, ws, gE + (off) + 16384); scan_ld1(E3, ws, gE + (off) + 24576); \
    Lv = ((const bf16_t*)(ws + O_RV))[gV + (off)]; } } while (0)
#define SCAN_ST(buf) do { if (isH) { scan_st1(E0, (buf), lE); scan_st1(E1, (buf), lE + 256); scan_st1(E2, (buf), lE + 512); scan_st1(E3, (buf), lE + 768); *(float*)((buf) + lV) = lo2f(Lv); } } while (0)
DEVI void scan_phase(const Params& p, char* shm) {
  const int tid = fresh_tid(), wid = tid >> 6, lane = tid & 63, blk = blockIdx.x;
  char* ws = p.ws;
  const int bh = blk >> 3, b = bh >> 4, h = bh & 15, rowb = (blk & 7) * 8;
  const bool isH = wid >= 4;
  const int hx = tid & 255;
  const size_t gE = ((size_t)b * SEQ + (hx >> 5)) * 1024 + h * 64 + (hx & 31) * 2;
  const size_t gV = ((size_t)b * SEQ + (hx >> 3)) * 1024 + h * 64 + rowb + (hx & 7);
  const int lE = hx, lV = SC_PV + hx * 4;
  const int g = blk * 256 + (tid - 256);
  const bool isC = (wid >= 4), isN = (isC && g < 1024);
  const int mbh = g >> 13, e4 = g & 8191, nbh = g >> 7, ndk = g & 127;
  float mm = 0.f, mn_ = 0.f, nn = 0.f; f32x4 C = (f32x4){0.f, 0.f, 0.f, 0.f}, dd = C; float dn = 0.f;
  const float* bLb = (const float*)(ws + O_BL); const float* gmb = (const float*)(ws + O_GMAX);
  if (isC) { const u32x2_t db = *(const u32x2_t*)((const bf16_t*)(ws + O_DC) + (size_t)(mbh * 64) * 32768 + e4 * 4); dd[0] = lo2f(db[0]); dd[1] = hi2f(db[0]); dd[2] = lo2f(db[1]); dd[3] = hi2f(db[1]); }
  float bLn = 0.f, gmn = 0.f;
  if (isC) { bLn = bLb[mbh * 64]; gmn = gmb[mbh * 64]; }
  if (isN) dn = ((const float*)(ws + O_DN))[(size_t)(nbh * 64) * 128 + ndk];
  const int rr = lane >> 5, cl = lane & 31, rowl = wid * 2 + rr;
  f32x2 st = (f32x2){0.f, 0.f};
  ScanE E0, E1, E2, E3; unsigned Lv = 0u;
  E0.w = E1.w = E2.w = E3.w = (f32x2){0.f, 0.f}; E0.kk = E0.ka = E0.k = E0.r = E1.kk = E1.ka = E1.k = E1.r = E2.kk = E2.ka = E2.k = E2.r = E3.kk = E3.ka = E3.k = E3.r = 0u;
  SCAN_LD((size_t)0);
  SCAN_ST(shm);
  SCAN_LD((size_t)SC_T * 1024);
  __syncthreads();
  for (int i = 0; i < SEQ / SC_T; ++i) {
    const bool more = (i + 1 < SEQ / SC_T);
    if (more) { char* nb = shm + ((i + 1) & 1) * SC_BUF; SCAN_ST(nb); }
    { const size_t adv = (size_t)(i + 2 < SEQ / SC_T ? i + 2 : i) * SC_T * 1024; SCAN_LD(adv); }
    if (wid < 4) {
      const char* buf = shm + (i & 1) * SC_BUF;
      float* yp = (float*)(shm + SC_YP + (i & 1) * SC_YPSZ) + wid * 64 + lane;
      const char* bA = buf + SC_PA + cl * 16; const char* bB = buf + SC_PB + cl * 16; const char* bC = buf + SC_PC + cl * 8;
      const char* bV = buf + SC_PV + rowl * 4;
      f32x4 a = *(const f32x4*)bA, bq = *(const f32x4*)bB; f32x2 r = *(const f32x2*)bC; float v = *(const float*)bV;
#pragma unroll 8
      for (int t = 0; t < SC_T; ++t) {
        const int tn = (t + 1 < SC_T) ? t + 1 : t;
        const f32x4 a2 = *(const f32x4*)(bA + tn * 512), b2 = *(const f32x4*)(bB + tn * 512);
        const f32x2 r2_ = *(const f32x2*)(bC + tn * 256); const float v2 = *(const float*)(bV + tn * 32);
        const f32x2 w = (f32x2){a[0], a[1]}, kk = (f32x2){a[2], a[3]}, ka = (f32x2){bq[0], bq[1]}, k = (f32x2){bq[2], bq[3]};
        const f32x2 pk = st * kk;
        const f32x2 tmp = st * w + v * k;
        const float sa = sum32(pk.x + pk.y);
        st = tmp - sa * ka;
        const f32x2 py = st * r;
        yp[t * 256] = py.x + py.y;
        a = a2; bq = b2; r = r2_; v = v2;
      }
    } else {
      if (i > 0) scan_yreduce(p, shm, i - 1, tid - 256, b, h, rowb);
      if (i == 9 || i == 49 || i == 89) { const int ct = blk * 4 + (wid - 4) + 1024 * (i / 40); if (ct < 2560) late_conv_task(p, ct, lane); }
    }
    if (wid >= 4 && (i & 1) == 0) {
      const int c = i >> 1, idx = mbh * 64 + c;
      {
        const float bL = bLn, gm = gmn;
        if (c < 63) { bLn = bLb[idx + 1]; gmn = gmb[idx + 1]; }
        const float mn = fmaxf(bL + mm, gm), cw = expf(bL + mm - mn), lw = expf(gm - mn);
        uint2 pk; pk.x = pack2(C[0], C[1]); pk.y = pack2(C[2], C[3]);
        *(uint2*)((bf16_t*)(ws + O_CST) + (size_t)idx * 32768 + e4 * 4) = pk;
        if (e4 == 0) ((float*)(ws + O_MST))[idx] = mm;
        C = cw * C + lw * dd;
        if (c < 63) { const u32x2_t db = __builtin_nontemporal_load((const u32x2_t*)((const bf16_t*)(ws + O_DC) + (size_t)(idx + 1) * 32768 + e4 * 4)); dd[0] = lo2f(db[0]); dd[1] = hi2f(db[0]); dd[2] = lo2f(db[1]); dd[3] = hi2f(db[1]); }
        mm = mn;
      }
      if (isN) {
        const int nidx = nbh * 64 + c;
        const float bL = bLb[nidx], gm = gmb[nidx];
        const float mn = fmaxf(bL + mn_, gm), cw = expf(bL + mn_ - mn), lw = expf(gm - mn);
        ((float*)(ws + O_NST))[(size_t)nidx * 128 + ndk] = nn;
        nn = cw * nn + lw * dn;
        if (c < 63) dn = ((const float*)(ws + O_DN))[(size_t)(nidx + 1) * 128 + ndk];
        mn_ = mn;
      }
    }
    __syncthreads();
  }
  if (wid >= 4) scan_yreduce(p, shm, SEQ / SC_T - 1, tid - 256, b, h, rowb);
  __syncthreads();
}

DEVI void rwkv_post(const Params& p, int gw, int GW, int lane) {
  char* ws = p.ws;
  const float* YS = (const float*)(ws + O_YS);
  const bf16_t* RR = (const bf16_t*)(ws + O_RR); const bf16_t* RK = (const bf16_t*)(ws + O_RK); const bf16_t* RV = (const bf16_t*)(ws + O_RV); const bf16_t* RG = (const bf16_t*)(ws + O_RG);
  bf16_t* HB = (bf16_t*)(ws + O_HB);
  const float* r_k = p.in[15]; const float* ln_g = p.in[16]; const float* ln_b = p.in[17];
#pragma unroll 1
  for (int pr0 = gw; pr0 < TOK * 16; pr0 += 4 * GW) {
    float y[4], r[4], k[4], v[4], g[4]; size_t o[4]; int chs[4];
#pragma unroll
    for (int j = 0; j < 4; ++j) {
      const int pr = pr0 + j * GW; const int prc = pr < TOK * 16 ? pr : pr0;
      const int t = prc >> 4, hh = prc & 15; chs[j] = hh * 64 + lane; o[j] = (size_t)t * 1024 + chs[j];
      y[j] = __builtin_nontemporal_load(YS + o[j]); r[j] = bf2f(__builtin_nontemporal_load(RR + o[j])); k[j] = bf2f(__builtin_nontemporal_load(RK + o[j])); v[j] = bf2f(__builtin_nontemporal_load(RV + o[j])); g[j] = bf2f(__builtin_nontemporal_load(RG + o[j]));
    }
#pragma unroll
    for (int j = 0; j < 4; ++j) {
      const int ch = chs[j];
      const float mean = wave_sum_fast(y[j]) * (1.f / 64.f);
      const float dlt = y[j] - mean;
      const float var = wave_sum_fast(dlt * dlt) * (1.f / 64.f);
      const float bonus = wave_sum_fast(r[j] * k[j] * r_k[ch]);
      const float yn = dlt * rsqrtf(var + 64e-5f) * ln_g[ch] + ln_b[ch];
      if (pr0 + j * GW < TOK * 16) HB[o[j]] = f2bf((yn + bonus * v[j]) * g[j]);
    }
  }
}

DEVI void xattn_task(const Params& p, int task, char* shm) {
  const int tid = fresh_tid(), wid = tid >> 6, lane = tid & 63, fr = lane & 15, fq = lane >> 4;
  char* ws = p.ws;
  const int qt = task & 31, hd = (task >> 5) & 3, b = task >> 7;
  const bf16_t* KV = (const bf16_t*)(ws + O_KV); const bf16_t* Q = (const bf16_t*)(ws + O_Q); bf16_t* OO = (bf16_t*)(ws + O_O);
  bf16_t* VT = (bf16_t*)shm;
  bf16_t* Pw = VT + 128 * 264 + wid * (16 * 264);
  const int r0 = b * SEQ + qt * 128 + wid * 16;
  bf16x8 afq[4];
#pragma unroll
  for (int ks = 0; ks < 4; ++ks) {
    const bf16_t* qp = Q + (size_t)(r0 + fr) * 512 + hd * 128 + ks * 32 + fq * 8;
    f32x4 q0 = (f32x4){0.f, 0.f, 0.f, 0.f}, q1 = q0;
#pragma unroll
    for (int sp = 0; sp < 4; ++sp) {
      const u32x4v_t qb = *(const u32x4v_t*)(qp + (size_t)sp * (TOK * 512));
      q0[0] += lo2f(qb[0]); q0[1] += hi2f(qb[0]); q0[2] += lo2f(qb[1]); q0[3] += hi2f(qb[1]);
      q1[0] += lo2f(qb[2]); q1[1] += hi2f(qb[2]); q1[2] += lo2f(qb[3]); q1[3] += hi2f(qb[3]);
    }
    union { unsigned u[4]; bf16x8 v; } qa; qa.u[0] = pack2(q0[0], q0[1]); qa.u[1] = pack2(q0[2], q0[3]); qa.u[2] = pack2(q1[0], q1[1]); qa.u[3] = pack2(q1[2], q1[3]);
    afq[ks] = qa.v;
  }
  bf16x8 kf0[16];
#pragma unroll
  for (int n = 0; n < 16; ++n) kf0[n] = *(const bf16x8*)(KV + (size_t)(b * 256 + n * 16 + fr) * 1024 + hd * 128 + fq * 8);
  for (int e = tid; e < 4096; e += 512) {
    const int m = e & 255, dg = e >> 8;
    const uint4 v = *(const uint4*)(KV + (size_t)(b * 256 + m) * 1024 + 512 + hd * 128 + dg * 8);
    bf16_t* dp = VT + (dg * 8) * 264 + m;
    dp[0 * 264] = (bf16_t)(v.x & 0xffff); dp[1 * 264] = (bf16_t)(v.x >> 16); dp[2 * 264] = (bf16_t)(v.y & 0xffff); dp[3 * 264] = (bf16_t)(v.y >> 16);
    dp[4 * 264] = (bf16_t)(v.z & 0xffff); dp[5 * 264] = (bf16_t)(v.z >> 16); dp[6 * 264] = (bf16_t)(v.w & 0xffff); dp[7 * 264] = (bf16_t)(v.w >> 16);
  }
  __syncthreads();
  f32x4 sc[16];
#pragma unroll
  for (int n = 0; n < 16; ++n) sc[n] = (f32x4){0.f, 0.f, 0.f, 0.f};
#pragma unroll
  for (int ks = 0; ks < 4; ++ks) {
    const bf16x8 af = afq[ks];
#pragma unroll
    for (int n = 0; n < 16; ++n) {
      const bf16x8 bfr = (ks == 0) ? kf0[n] : *(const bf16x8*)(KV + (size_t)(b * 256 + n * 16 + fr) * 1024 + hd * 128 + ks * 32 + fq * 8);
      sc[n] = MFMA16(af, bfr, sc[n]);
    }
  }
  float rinv[4];
#pragma unroll
  for (int j = 0; j < 4; ++j) {
    float mx = -INFINITY;
#pragma unroll
    for (int n = 0; n < 16; ++n) mx = fmaxf(mx, sc[n][j]);
    mx = max16(mx) * 0.08838834764831845f;
    float sm = 0.f;
#pragma unroll
    for (int n = 0; n < 16; ++n) { const float e = __expf(sc[n][j] * 0.08838834764831845f - mx); sm += e; Pw[(fq * 4 + j) * 264 + n * 16 + fr] = f2bf(e); }
    rinv[j] = 1.f / sum16(sm);
  }
  __syncthreads();
  f32x4 oa[8];
#pragma unroll
  for (int n = 0; n < 8; ++n) oa[n] = (f32x4){0.f, 0.f, 0.f, 0.f};
#pragma unroll
  for (int ks = 0; ks < 8; ++ks) {
    const bf16x8 af = *(const bf16x8*)(Pw + fr * 264 + ks * 32 + fq * 8);
#pragma unroll
    for (int n = 0; n < 8; ++n) {
      const bf16x8 bfr = *(const bf16x8*)(VT + (n * 16 + fr) * 264 + ks * 32 + fq * 8);
      oa[n] = MFMA16(af, bfr, oa[n]);
    }
  }
#pragma unroll
  for (int n = 0; n < 8; ++n)
#pragma unroll
    for (int j = 0; j < 4; ++j) OO[(size_t)(r0 + fq * 4 + j) * 512 + hd * 128 + n * 16 + fr] = f2bf(oa[n][j] * rinv[j]);
  __syncthreads();
}

DEVI void conv_glu(const Params& p, int gt, int GT) {
  char* ws = p.ws;
  const bf16_t* U = (const bf16_t*)(ws + O_U); bf16_t* ACT = (bf16_t*)(ws + O_ACT);
  const float* cw = p.in[30]; const float* cb = p.in[31];
  for (int task = gt; task < 256 * 1024; task += GT) {
    const int jg = task & 1023, run = task >> 10, j0 = jg * 8, t0 = run * 32;
    float w[3][16], bb[16];
#pragma unroll
    for (int i = 0; i < 8; ++i) {
      bb[i] = cb[j0 + i]; bb[8 + i] = cb[8192 + j0 + i];
#pragma unroll
      for (int tp = 0; tp < 3; ++tp) { w[tp][i] = cw[tp * 16384 + j0 + i]; w[tp][8 + i] = cw[tp * 16384 + 8192 + j0 + i]; }
    }
    float p1[16], p2[16];
    auto ld16 = [&](int t, float* o) {
      typedef unsigned u32x4_t __attribute__((ext_vector_type(4)));
      const u32x4_t a_ = __builtin_nontemporal_load((const u32x4_t*)(U + (size_t)t * 16384 + j0)), c_ = __builtin_nontemporal_load((const u32x4_t*)(U + (size_t)t * 16384 + 8192 + j0));
      uint4 a, c; a.x = a_[0]; a.y = a_[1]; a.z = a_[2]; a.w = a_[3]; c.x = c_[0]; c.y = c_[1]; c.z = c_[2]; c.w = c_[3];
      o[0] = lo2f(a.x); o[1] = hi2f(a.x); o[2] = lo2f(a.y); o[3] = hi2f(a.y); o[4] = lo2f(a.z); o[5] = hi2f(a.z); o[6] = lo2f(a.w); o[7] = hi2f(a.w);
      o[8] = lo2f(c.x); o[9] = hi2f(c.x); o[10] = lo2f(c.y); o[11] = hi2f(c.y); o[12] = lo2f(c.z); o[13] = hi2f(c.z); o[14] = lo2f(c.w); o[15] = hi2f(c.w);
    };
    if ((t0 % SEQ) > 0) { ld16(t0 - 1, p1); ld16(t0 - 2, p2); }
    else {
#pragma unroll
      for (int i = 0; i < 16; ++i) { p1[i] = 0.f; p2[i] = 0.f; }
    }
#pragma unroll 1
    for (int tt = 0; tt < 32; tt += 4) {
      float c0[16], c1[16], c2[16], c3[16];
      ld16(t0 + tt, c0); ld16(t0 + tt + 1, c1); ld16(t0 + tt + 2, c2); ld16(t0 + tt + 3, c3);
      auto one = [&](const float* pp2, const float* pp1, const float* cur, int t) {
        float res[8];
#pragma unroll
        for (int i = 0; i < 8; ++i) {
          const float gt_ = bb[i] + w[0][i] * pp2[i] + w[1][i] * pp1[i] + w[2][i] * cur[i];
          const float up = bb[8 + i] + w[0][8 + i] * pp2[8 + i] + w[1][8 + i] * pp1[8 + i] + w[2][8 + i] * cur[8 + i];
          const float z = 1.5957691216057308f * (gt_ + 0.044715f * gt_ * gt_ * gt_);
          res[i] = gt_ * sigmoidf_(z) * up;
        }
        uint4 o; o.x = pack2(res[0], res[1]); o.y = pack2(res[2], res[3]); o.z = pack2(res[4], res[5]); o.w = pack2(res[6], res[7]);
        *(uint4*)(ACT + (size_t)t * 8192 + j0) = o;
      };
      one(p2, p1, c0, t0 + tt); one(p1, c0, c1, t0 + tt + 1); one(c0, c1, c2, t0 + tt + 2); one(c1, c2, c3, t0 + tt + 3);
#pragma unroll
      for (int i = 0; i < 16; ++i) { p2[i] = c2[i]; p1[i] = c3[i]; }
    }
  }
}

#define XB_TMO      128
#define XB_XCNT(j)  (256  + 64 * (j))
#define XB_XSUB(j)  (1280 + 64 * (j))
#define XB_XGEN(j)  (2304 + 64 * (j))
#define XB_TOP      3328
#define XB_TOPGEN   3392
#define XCD_BAR_WORDS 3456
#define XB_SPIN_CAP (1u << 20)
#define LAS __attribute__((address_space(3)))
DEVI unsigned xb_ld(unsigned* p)              { return __hip_atomic_load(p, __ATOMIC_RELAXED, __HIP_MEMORY_SCOPE_AGENT); }
DEVI unsigned xb_add(unsigned* p, unsigned v) { return __hip_atomic_fetch_add(p, v, __ATOMIC_RELAXED, __HIP_MEMORY_SCOPE_AGENT); }
DEVI unsigned xb_xcc_id() { return (unsigned)__builtin_amdgcn_s_getreg((3 << 11) | 20) & 0xFu; }
#define XB_SPIN(cond, bar) do { unsigned _sp = 0; while (cond) { __builtin_amdgcn_s_sleep(1); \
    if ((++_sp & 255u) == 0u) { if (xb_ld(&(bar)[XB_TMO])) break; if (_sp > XB_SPIN_CAP) { atomicAdd(&(bar)[XB_TMO], 1u); break; } } } } while (0)
struct XcdBarrier { unsigned* bar; unsigned x; volatile LAS unsigned* st; };
DEVI XcdBarrier xcd_barrier_post(unsigned* bar, volatile LAS unsigned* st) {
  XcdBarrier b; b.bar = bar; b.x = xb_xcc_id(); b.st = st;
  if (threadIdx.x == 0) (void)xb_add(&bar[XB_XCNT(b.x)], 1u);
  return b;
}
DEVI void xcd_barrier_complete(unsigned* bar, unsigned x, unsigned& nloc, unsigned& nx) {
  const unsigned G = gridDim.x * gridDim.y * gridDim.z;
  unsigned sum, cnt, mine, sp = 0u;
  for (;;) {
    sum = 0u; cnt = 0u; mine = 0u;
#pragma unroll
    for (unsigned j = 0; j < 16; ++j) { const unsigned c = xb_ld(&bar[XB_XCNT(j)]); sum += c; cnt += (c > 0u) ? 1u : 0u; mine = (j == x) ? c : mine; }
    if (sum == G) break;
    __builtin_amdgcn_s_sleep(1);
    if ((++sp & 255u) == 0u) { if (xb_ld(&bar[XB_TMO])) break; if (sp > XB_SPIN_CAP) { atomicAdd(&bar[XB_TMO], 1u); break; } }
  }
  nloc = mine > 0u ? mine : 1u; nx = cnt > 0u ? cnt : 1u;
}
DEVI void xcd_barrier(const XcdBarrier& b) {
  asm volatile("s_waitcnt vmcnt(0)" ::: "memory");
  __syncthreads();
  if (threadIdx.x == 0) {
    unsigned* bar = b.bar;
    __builtin_amdgcn_s_waitcnt(0);
    unsigned nloc = b.st[0], nx = b.st[1];
    if (nloc == 0u) { xcd_barrier_complete(bar, b.x, nloc, nx); b.st[0] = nloc; b.st[1] = nx; }
    const unsigned old = xb_add(&bar[XB_XSUB(b.x)], 1u);
    const unsigned gen = old / nloc;
    if (old + 1u == (gen + 1u) * nloc) {
      __builtin_amdgcn_fence(__ATOMIC_RELEASE, "agent");
      asm volatile("s_waitcnt vmcnt(0)" ::: "memory");
      const unsigned og = xb_add(&bar[XB_TOP], 1u);
      const unsigned tg = og / nx;
      if (og + 1u == (tg + 1u) * nx) xb_add(&bar[XB_TOPGEN], 1u);
      else XB_SPIN(xb_ld(&bar[XB_TOPGEN]) == tg, bar);
      __builtin_amdgcn_fence(__ATOMIC_ACQUIRE, "agent");
      xb_add(&bar[XB_XGEN(b.x)], 1u);
      asm volatile("s_waitcnt vmcnt(0)" ::: "memory");
    } else {
      XB_SPIN(xb_ld(&bar[XB_XGEN(b.x)]) == gen, bar);
      __builtin_amdgcn_fence(__ATOMIC_ACQUIRE, "agent");
      asm volatile("s_waitcnt vmcnt(0)" ::: "memory");
    }
  }
  __syncthreads();
}

__global__ void __launch_bounds__(512) mega(Params p_arg) {
  const Params& p = *(const Params*)__builtin_amdgcn_kernarg_segment_ptr();
  extern __shared__ __attribute__((aligned(16))) char shm[];
  cg::grid_group grid = cg::this_grid();
  const int G = gridDim.x, blk = blockIdx.x, GW = G * 8;
  char* ws = p.ws;
  if (ws == nullptr) grid.sync();
  volatile LAS unsigned* xst = (volatile LAS unsigned*)(shm + LDS_BYTES - 16);
  if (threadIdx.x == 0) { xst[0] = 0u; xst[1] = 0u; }
  __syncthreads();
  const XcdBarrier xb = xcd_barrier_post((unsigned*)(ws + O_BAR), xst);
#define GRID_SYNC() xcd_barrier(xb)
#define LOCALS const int tid = fresh_tid(), wid = tid >> 6, lane = tid & 63, gw = blk * 8 + wid; (void)gw; (void)lane; (void)wid;

  { LOCALS
    float* cscr = (float*)shm + wid * (64 * 65);
    conv_weight_lds(p.in[3], NIN, 2048, NPROJ, (bf16_t*)(ws + O_WIN), 1, gw, GW, lane, cscr, false);
    conv_weight_lds(p.in[25], 1024, 2048, 1024, (bf16_t*)(ws + O_WKV), 0, gw, GW, lane, cscr, false);
    for (int r = gw; r < TOK + 512; r += GW) {
      if (r < TOK) rms_row_bf16(p.in[0] + (size_t)r * DM, p.in[2], (bf16_t*)(ws + O_HN) + (size_t)r * DM, lane);
      else rms_row_bf16(p.in[1] + (size_t)(r - TOK) * DM, p.in[23], (bf16_t*)(ws + O_MN) + (size_t)(r - TOK) * DM, lane);
    }
    const int gt = blk * 512 + tid, GT = G * 512;
    for (int i = gt; i < 3 * TOK; i += GT) ((float*)(ws + O_SS))[i] = 0.f;
    bf16_t* wl = (bf16_t*)(ws + O_WLR);
    for (int i = gt; i < 1024 * 288; i += GT) {
      if (i < 65536) { const int c = i >> 6, k = i & 63; wl[i] = f2bf(p.in[9][k * 1024 + c]); }
      else if (i < 131072) { const int q = i - 65536, c = q >> 6, k = q & 63; wl[i] = f2bf(p.in[11][k * 1024 + c]); }
      else { const int q = i - 131072, c = q / 160, k = q % 160; wl[i] = f2bf(p.in[12][k * 1024 + c]); }
    }
  }
  GRID_SYNC();

  const bf16_t* nullbf = nullptr;
  { GD d{(const bf16_t*)(ws + O_HN), (const bf16_t*)(ws + O_WIN), 2048, 2048, 2048, 32, 42, 0, 0, ws + O_PROJ, NPROJ, (float*)(ws + O_TAIL), nullbf, nullptr};
    gemm_phase<0>(d, shm); }
  { GD d{(const bf16_t*)(ws + O_MN), (const bf16_t*)(ws + O_WKV), 2048, 2048, 2048, 2, 4, 0, 64 % G, ws + O_KV, 1024, nullptr, nullbf, nullptr};
    gemm_phase<0>(d, shm); }
  GRID_SYNC();
  for (int t = blk; t < 768; t += G) { if (t < 256) rwkv_prep_tile(p, t, shm); else mlstm_A(p, t - 256, shm); }
  GRID_SYNC();
  if (G == 256) scan_phase(p, shm);
  GRID_SYNC();
  for (int t = blk; t < 512; t += G) mlstm_D(p, t, shm);
  { LOCALS rwkv_post(p, gw, GW, lane); }
  GRID_SYNC();
  { GD da{(const bf16_t*)(ws + O_HA), (const bf16_t*)(ws + O_WA), 1024, 1024, 1024, 32, 8, 2, 0, nullptr, 0, (float*)(ws + O_MTMP), (const bf16_t*)(ws + O_PROJ) + 6144, nullptr};
    GD db{(const bf16_t*)(ws + O_HB), (const bf16_t*)(ws + O_WB), 1024, 1024, 1024, 32, 8, 3, 0, ws + O_MERGED, 2048, (float*)(ws + O_MTMP), (const bf16_t*)(ws + O_PROJ) + 8192, nullptr};
    for (int i = 0;; ++i) {
      int pm, pn;
      if (!tile_of((long)i * G + blk, 32, 8, pm, pn)) break;
      gemm_tile<2>(da, pm, pn, (lds_u8*)shm);
      gemm_tile<3>(db, pm, pn, (lds_u8*)shm);
    } }
  GRID_SYNC();
  { GD d{(const bf16_t*)(ws + O_MERGED), (const bf16_t*)(ws + O_WOUT), 2048, 2048, 2048, 32, 8, 1, 0, ws + O_Y, 2048, nullptr, nullbf, (float*)(ws + O_SS)};
    gemm_phase<1>(d, shm); }
  GRID_SYNC();
  { LOCALS
  for (int r = gw; r < TOK; r += GW)
    resid_row<false, true>(p.in[0] + (size_t)r * DM, (const bf16_t*)(ws + O_Y) + (size_t)r * DM, ((const float*)(ws + O_SS))[r], p.in[21],
              (bf16_t*)(ws + O_X1) + (size_t)r * DM, p.in[22], (bf16_t*)(ws + O_H2) + (size_t)r * DM, lane);
  float* cscr = (float*)shm + wid * (64 * 65);
  conv_weight_lds(p.in[29], 16384, 2048, 16384, (bf16_t*)(ws + O_WUP), 0, gw, GW, lane, cscr, true);
  conv_weight_lds(p.in[32], 2048, 8192, 2048, (bf16_t*)(ws + O_WDN), 0, gw, GW, lane, cscr, true); }
  GRID_SYNC();
  for (int u = blk; u < 256; u += G) {
    const int sp = u >> 6;
    GD d{(const bf16_t*)(ws + O_H2) + sp * 512, (const bf16_t*)(ws + O_WQ) + sp * 512, 2048, 2048, 512, 32, 2, 4, 0, ws + O_Q + (size_t)sp * (8 * MiB), 512, nullptr, nullbf, nullptr};
    int pm, pn;
    if (tile_of(u & 63, 32, 2, pm, pn)) gemm_tile<4>(d, pm, pn, (lds_u8*)shm);
  }
  GRID_SYNC();
  for (int t = blk; t < 256; t += G) xattn_task(p, t, shm);
  GRID_SYNC();
  { GD d{(const bf16_t*)(ws + O_O), (const bf16_t*)(ws + O_WO), 512, 512, 512, 32, 8, 1, 0, ws + O_Y, 2048, nullptr, nullbf, (float*)(ws + O_SS) + TOK};
    gemm_phase<1>(d, shm); }
  GRID_SYNC();
  { LOCALS
  for (int r = gw; r < TOK; r += GW)
    resid_row<true, true>((const bf16_t*)(ws + O_X1) + (size_t)r * DM, (const bf16_t*)(ws + O_Y) + (size_t)r * DM, ((const float*)(ws + O_SS))[TOK + r], p.in[27],
              (bf16_t*)(ws + O_X2) + (size_t)r * DM, p.in[28], (bf16_t*)(ws + O_H3) + (size_t)r * DM, lane); }
  GRID_SYNC();
  { GD d{(const bf16_t*)(ws + O_H3), (const bf16_t*)(ws + O_WUP), 2048, 2048, 2048, 32, 64, 0, 0, ws + O_U, 16384, nullptr, nullbf, nullptr};
    gemm_phase<0>(d, shm); }
  GRID_SYNC();
  { LOCALS conv_glu(p, blk * 512 + tid, G * 512); }
  GRID_SYNC();
  { GD d{(const bf16_t*)(ws + O_ACT), (const bf16_t*)(ws + O_WDN), 8192, 8192, 8192, 32, 8, 1, 0, ws + O_Y3, 2048, nullptr, nullbf, (float*)(ws + O_SS) + 2 * TOK};
    gemm_phase<1>(d, shm); }
  GRID_SYNC();
  { LOCALS
  for (int r = gw; r < TOK; r += GW)
    resid_row<true, false>((const bf16_t*)(ws + O_X2) + (size_t)r * DM, (const bf16_t*)(ws + O_Y3) + (size_t)r * DM, ((const float*)(ws + O_SS))[2 * TOK + r], p.in[33],
              p.out + (size_t)r * DM, nullptr, nullptr, lane); }
}

extern "C" void kernel_launch(void* const* d_in, const int* in_sizes, int n_in, void* d_out, int out_size, void* d_ws, size_t ws_size, hipStream_t stream) {
  static int grid_blocks = 0;
  if (!grid_blocks) {
    int dev = 0, cus = 0, per_cu = 0;
    hipGetDevice(&dev);
    hipDeviceGetAttribute(&cus, hipDeviceAttributeMultiprocessorCount, dev);
    hipFuncSetAttribute((const void*)mega, hipFuncAttributeMaxDynamicSharedMemorySize, LDS_BYTES);
    hipOccupancyMaxActiveBlocksPerMultiprocessor(&per_cu, (const void*)mega, 512, LDS_BYTES);
    if (per_cu < 1) per_cu = 1;
    grid_blocks = cus * per_cu;
    if (ws_size < 512 * MiB) fprintf(stderr, "workspace too small: %zu\n", ws_size);
  }
  (void)hipMemsetAsync((char*)d_ws + O_BAR, 0, XCD_BAR_WORDS * 4, stream);
  Params p{};
  for (int i = 0; i < 34; ++i) p.in[i] = (const float*)d_in[i];
  p.out = (float*)d_out; p.ws = (char*)d_ws;
  void* args[] = {&p};
  hipError_t e = hipLaunchCooperativeKernel((const void*)mega, dim3(grid_blocks), dim3(512), args, LDS_BYTES, stream);
  if (e != hipSuccess) fprintf(stderr, "cooperative launch failed: %s (grid %d)\n", hipGetErrorString(e), grid_blocks);
}
```

```cpp
#include <hip/hip_runtime.h>
#include <hip/hip_cooperative_groups.h>
#include <cstdio>
namespace cg = cooperative_groups;

typedef unsigned short bf16_t;
typedef short bf16x8 __attribute__((ext_vector_type(8)));
typedef float f32x4 __attribute__((ext_vector_type(4)));
typedef unsigned u32x2_t __attribute__((ext_vector_type(2)));
typedef unsigned u32x4v_t __attribute__((ext_vector_type(4)));
#define DEVI __device__ __forceinline__

constexpr int TOK = 8192, DM = 2048, SEQ = 4096, NPROJ = 10752, NIN = 10536;
constexpr int LDS_BYTES = 155648;
constexpr size_t MiB = 1048576;

constexpr size_t O_Z      = 0;
constexpr size_t O_SS     = O_Z;
constexpr size_t O_BCUM   = O_Z + 98304;
constexpr size_t O_IG     = O_BCUM + 131072;
constexpr size_t O_GMAX   = O_IG + 131072;
constexpr size_t O_BL     = O_GMAX + 2048;
constexpr size_t O_MST    = O_BL + 2048;
constexpr size_t O_DN     = O_MST + 2048;
constexpr size_t O_NST    = O_DN + 262144;
constexpr size_t O_BAR    = 917504;
constexpr size_t O_KV     = 1 * MiB;
constexpr size_t O_WLR    = 2 * MiB;
constexpr size_t O_WA     = 8 * MiB, O_WB = 12 * MiB, O_WOUT = 16 * MiB, O_WQ = 24 * MiB, O_WKV = 26 * MiB, O_WO = 30 * MiB;
constexpr size_t O_WIN    = 32 * MiB;
constexpr size_t O_HN     = 74 * MiB;
constexpr size_t O_MN     = 106 * MiB;
constexpr size_t O_DC     = 32 * MiB;
constexpr size_t O_MTMP   = 32 * MiB;
constexpr size_t O_Q      = 108 * MiB, O_O = 40 * MiB, O_H2 = 48 * MiB;
constexpr size_t O_PROJ   = 108 * MiB;
constexpr size_t O_TAIL   = 276 * MiB;
constexpr size_t O_RR     = 292 * MiB, O_RK = 308 * MiB, O_RV = 324 * MiB, O_RG = 340 * MiB, O_RKK = 356 * MiB, O_RKA = 372 * MiB, O_RW = 388 * MiB;
constexpr size_t O_HA     = 356 * MiB, O_HB = 372 * MiB;
constexpr size_t O_YS     = 420 * MiB;
constexpr size_t O_MERGED = 420 * MiB;
constexpr size_t O_CST    = 452 * MiB;
constexpr size_t O_Y      = 108 * MiB, O_X1 = 172 * MiB;
constexpr size_t O_X2     = 264 * MiB;
constexpr size_t O_WDN    = 328 * MiB;
constexpr size_t O_WUP    = 360 * MiB;
constexpr size_t O_H3     = 424 * MiB;
constexpr size_t O_U      = 8 * MiB;
constexpr size_t O_ACT    = 360 * MiB;
constexpr size_t O_Y3     = 8 * MiB;

struct Params { const float* in[34]; float* out; char* ws; };

typedef __bf16 bf16v2_t __attribute__((ext_vector_type(2)));
typedef float f32x2_t __attribute__((ext_vector_type(2)));
DEVI unsigned pack2(float a, float b) { const f32x2_t v = {a, b}; const bf16v2_t r = __builtin_convertvector(v, bf16v2_t); return __builtin_bit_cast(unsigned, r); }
DEVI bf16_t f2bf(float f) { return (bf16_t)(pack2(f, 0.f) & 0xffffu); }
DEVI unsigned pack2_sw(float a, float b) {
  unsigned u = __float_as_uint(a), w = __float_as_uint(b); u += 0x7fffu + ((u >> 16) & 1u); w += 0x7fffu + ((w >> 16) & 1u); return (u >> 16) | (w & 0xffff0000u); }
DEVI float bf2f(bf16_t b) { return __uint_as_float(((unsigned)b) << 16); }
DEVI float lo2f(unsigned u) { return __uint_as_float(u << 16); }
DEVI float hi2f(unsigned u) { return __uint_as_float(u & 0xffff0000u); }
DEVI float sigmoidf_(float x) { return 1.f / (1.f + __expf(-x)); }
DEVI float wave_sum(float v) {
#pragma unroll
  for (int o = 1; o < 64; o <<= 1) v += __shfl_xor(v, o);
  return v;
}
DEVI float dpp_sum16(float x);
DEVI float wave_sum_fast(float x) {
  x = dpp_sum16(x);
  const unsigned a = __float_as_uint(x);
  const auto r = __builtin_amdgcn_permlane16_swap(a, a, false, false);
  const float y = __uint_as_float(r[0]) + __uint_as_float(r[1]);
  const unsigned c = __float_as_uint(y);
  const auto q = __builtin_amdgcn_permlane32_swap(c, c, false, false);
  return __uint_as_float(q[0]) + __uint_as_float(q[1]);
}
DEVI float wave_max(float v) {
#pragma unroll
  for (int o = 1; o < 64; o <<= 1) v = fmaxf(v, __shfl_xor(v, o));
  return v;
}
DEVI float sum16(float v) { v += __shfl_xor(v, 1); v += __shfl_xor(v, 2); v += __shfl_xor(v, 4); v += __shfl_xor(v, 8); return v; }
DEVI float max16(float v) { v = fmaxf(v, __shfl_xor(v, 1)); v = fmaxf(v, __shfl_xor(v, 2)); v = fmaxf(v, __shfl_xor(v, 4)); v = fmaxf(v, __shfl_xor(v, 8)); return v; }
DEVI float dpp_sum16(float x) {
  x += __builtin_bit_cast(float, __builtin_amdgcn_update_dpp(0, __builtin_bit_cast(int, x), 0xB1, 0xf, 0xf, true));
  x += __builtin_bit_cast(float, __builtin_amdgcn_update_dpp(0, __builtin_bit_cast(int, x), 0x4E, 0xf, 0xf, true));
  x += __builtin_bit_cast(float, __builtin_amdgcn_update_dpp(0, __builtin_bit_cast(int, x), 0x141, 0xf, 0xf, true));
  x += __builtin_bit_cast(float, __builtin_amdgcn_update_dpp(0, __builtin_bit_cast(int, x), 0x140, 0xf, 0xf, true));
  return x;
}
DEVI int fresh_tid() { int t = threadIdx.x; asm volatile("" : "+v"(t)); return t; }
#define MFMA16(a, b, c) __builtin_amdgcn_mfma_f32_16x16x32_bf16((a), (b), (c), 0, 0, 0)

constexpr int BM = 256, BK = 64, HALF = 128, HT = HALF * BK, NXCD = 8, WGM = 4;
DEVI int lds_byte(int r, int c) { int st = (r >> 4) * 2 + (c >> 5), rr = r & 15, cc = c & 31, ob = rr * 64 + cc * 2; return st * 1024 + (ob ^ (((ob >> 9) & 1) << 5)); }
DEVI void stage_rc(int b, int& R, int& C) { int st = b / 1024, sb = b % 1024, swz = sb ^ (((sb >> 9) & 1) << 5); R = (st >> 1) * 16 + swz / 64; C = (st & 1) * 32 + (swz % 64) / 2; }

struct GD {
  const bf16_t* A; const bf16_t* Bt; int lda, ldb, K, nM, nN, mode, boff;
  void* O; int ldo; float* aux; const bf16_t* gate; float* ss;
};

DEVI bool tile_of(long L, int nM, int nN, int& pm, int& pn) {
  const int nwg = nM * nN; if (L >= nwg) return false;
  int wgid = (int)L; { const int q = nwg / NXCD, r = nwg % NXCD, xcd = wgid % NXCD, off = wgid / NXCD; wgid = (xcd < r ? xcd * (q + 1) : r * (q + 1) + (xcd - r) * q) + off; }
  const int nig = WGM * nN, gid = wgid / nig, fm = gid * WGM, gsz = (nM - fm) < WGM ? (nM - fm) : WGM;
  pm = fm + ((wgid % nig) % gsz); pn = (wgid % nig) / gsz; return true;
}

typedef __attribute__((address_space(3))) unsigned char lds_u8;
template <int MODE>
DEVI void gemm_tile(const GD& d, const int pm, const int pn, lds_u8* lds, const bool staged = false, const bool has_next = false, const int npm = 0, const int npn = 0) {
  const int tid = fresh_tid(), wid = __builtin_amdgcn_readfirstlane(tid >> 6), lane = tid & 63, wr = wid >> 2, wc = wid & 3, fr = lane & 15, fq = lane >> 4;
  const int lda = d.lda, ldb = d.ldb;
  unsigned voffA[2], voffB[2];
#pragma unroll
  for (int i = 0; i < 2; ++i) { int R, C; stage_rc(tid * 16 + i * 8192, R, C); voffA[i] = (unsigned)(R * lda + C) * 2u; voffB[i] = (unsigned)(R * ldb + C) * 2u; }
  const size_t kstep = (size_t)(BK * 2);
  const size_t hstepA = (size_t)HALF * lda * 2, hstepB = (size_t)HALF * ldb * 2;
  const unsigned ldsw = (unsigned)wid * 1024u;
  const int aoff = lds_byte(wr * 64 + fr, fq * 8), boff = lds_byte(wc * 32 + fr, fq * 8);
  constexpr int HTB = HT * 2;
#define SA(b, h) (((b) * 2 + (h)) * HTB)
#define SB(b, h) ((4 + (b) * 2 + (h)) * HTB)
#define STAGE(bufoff, gbase, voff) do { _Pragma("unroll") for (int _i = 0; _i < 2; ++_i) \
    __builtin_amdgcn_global_load_lds((const unsigned*)((const char*)(gbase) + (voff)[_i]), (__attribute__((address_space(3))) unsigned*)(lds + (bufoff) + ldsw + _i * 8192), 16, 0, 0); } while (0)
#define LDA(dst, b, h) do { _Pragma("unroll") for (int m = 0; m < 4; ++m) _Pragma("unroll") for (int k = 0; k < 2; ++k) dst[m][k] = *(const __attribute__((address_space(3))) bf16x8*)(lds + SA(b, h) + aoff + m * 2048 + k * 1024); } while (0)
#define LDB(dst, b, h) do { _Pragma("unroll") for (int n = 0; n < 2; ++n) _Pragma("unroll") for (int k = 0; k < 2; ++k) dst[n][k] = *(const __attribute__((address_space(3))) bf16x8*)(lds + SB(b, h) + boff + n * 2048 + k * 1024); } while (0)
#define MMA(ai, bj, At_, Bt_) do { __builtin_amdgcn_s_setprio(1); \
    _Pragma("unroll") for (int m = 0; m < 4; ++m) _Pragma("unroll") for (int n = 0; n < 2; ++n) _Pragma("unroll") for (int k = 0; k < 2; ++k) \
      acc[ai][bj][m][n] = MFMA16(Bt_[n][k], At_[m][k], acc[ai][bj][m][n]); \
    __builtin_amdgcn_s_setprio(0); } while (0)
#define WAIT_V(n) asm volatile("s_waitcnt vmcnt(" #n ")" ::: "memory")
#define WAIT_L(n) asm volatile("s_waitcnt lgkmcnt(" #n ")" ::: "memory")
#define BAR __builtin_amdgcn_s_barrier()
#define SCHED __builtin_amdgcn_sched_barrier(0)
  const int brow = pm * BM, bcol = pn * BM;
  const char* cA = (const char*)d.A + (size_t)brow * lda * 2;
  const char* cB = (const char*)d.Bt + (size_t)bcol * ldb * 2;
  f32x4 acc[2][2][4][2];
#pragma unroll
  for (int a = 0; a < 2; ++a)
#pragma unroll
    for (int b = 0; b < 2; ++b)
#pragma unroll
      for (int m = 0; m < 4; ++m)
#pragma unroll
        for (int n = 0; n < 2; ++n) acc[a][b][m][n] = (f32x4){0.f, 0.f, 0.f, 0.f};
  bf16x8 At[4][2], B0[2][2], B1[2][2];
  const int nt = d.K / BK;
  if (!staged) {
    STAGE(SB(0, 0), cB, voffB); STAGE(SA(0, 0), cA, voffA); STAGE(SB(0, 1), cB + hstepB, voffB); STAGE(SA(0, 1), cA + hstepA, voffA);
    if (wr == 1) BAR;
    WAIT_V(4); BAR;
    STAGE(SB(1, 0), cB + kstep, voffB); STAGE(SA(1, 0), cA + kstep, voffA); STAGE(SB(1, 1), cB + hstepB + kstep, voffB);
    WAIT_V(6); BAR;
  } else {
    if (wr == 1) BAR;
    BAR; BAR;
  }
  for (int t = 0; t < nt - 2; t += 2) {
    const char* a1 = cA + (size_t)(t + 1) * kstep;
    const char* a2 = cA + (size_t)(t + 2) * kstep; const char* b2 = cB + (size_t)(t + 2) * kstep;
    const char* a3 = a2 + kstep; const char* b3 = b2 + kstep;
    LDB(B0, 0, 0); SCHED; LDA(At, 0, 0); STAGE(SA(1, 1), a1 + hstepA, voffA);
    WAIT_L(8); BAR; WAIT_L(0); MMA(0, 0, At, B0); BAR; SCHED;
    LDB(B1, 0, 1); STAGE(SB(0, 0), b2, voffB);
    BAR; WAIT_L(0); MMA(0, 1, At, B1); BAR;
    LDA(At, 0, 1); STAGE(SA(0, 0), a2, voffA);
    BAR; WAIT_L(0); MMA(1, 0, At, B0); BAR; SCHED;
    STAGE(SB(0, 1), b2 + hstepB, voffB);
    WAIT_V(6); BAR; MMA(1, 1, At, B1); BAR;
    LDB(B0, 1, 0); SCHED; LDA(At, 1, 0); STAGE(SA(0, 1), a2 + hstepA, voffA);
    WAIT_L(8); BAR; WAIT_L(0); MMA(0, 0, At, B0); BAR; SCHED;
    LDB(B1, 1, 1); STAGE(SB(1, 0), b3, voffB);
    BAR; WAIT_L(0); MMA(0, 1, At, B1); BAR;
    LDA(At, 1, 1); STAGE(SA(1, 0), a3, voffA);
    BAR; WAIT_L(0); MMA(1, 0, At, B0); BAR; SCHED;
    STAGE(SB(1, 1), b3 + hstepB, voffB);
    WAIT_V(6); BAR; MMA(1, 1, At, B1); BAR;
  }
  { LDB(B0, 0, 0); LDA(At, 0, 0); STAGE(SA(1, 1), cA + (size_t)(nt - 1) * kstep + hstepA, voffA);
    BAR; WAIT_L(0); MMA(0, 0, At, B0); BAR;
    LDB(B1, 0, 1); BAR; WAIT_L(0); MMA(0, 1, At, B1); BAR;
    LDA(At, 0, 1); WAIT_V(4); BAR; WAIT_L(0); MMA(1, 0, At, B0); MMA(1, 1, At, B1); BAR; }
  { LDB(B0, 1, 0); LDA(At, 1, 0); WAIT_V(2); BAR; WAIT_L(0); MMA(0, 0, At, B0); BAR;
    LDB(B1, 1, 1); WAIT_V(0); BAR; WAIT_L(0); MMA(0, 1, At, B1); BAR;
    LDA(At, 1, 1); BAR; WAIT_L(0); MMA(1, 0, At, B0); MMA(1, 1, At, B1); BAR; }
  if (wr == 0) BAR;
  if (has_next) {
    const char* nA = (const char*)d.A + (size_t)npm * BM * lda * 2;
    const char* nB = (const char*)d.Bt + (size_t)npn * BM * ldb * 2;
    STAGE(SB(0, 0), nB, voffB); STAGE(SA(0, 0), nA, voffA); STAGE(SB(0, 1), nB + hstepB, voffB); STAGE(SA(0, 1), nA + hstepA, voffA);
    STAGE(SB(1, 0), nB + kstep, voffB); STAGE(SA(1, 0), nA + kstep, voffA); STAGE(SB(1, 1), nB + hstepB + kstep, voffB);
  }
  u32x4v_t gpre[2]; f32x4 tpre[2][2];
  auto ld_group = [&](int ai_, int m_) __attribute__((always_inline)) {
    const int row_ = brow + ai_ * HALF + wr * 64 + m_ * 16 + fr;
#pragma unroll
    for (int bj = 0; bj < 2; ++bj) {
      const int col_ = bcol + bj * HALF + wc * 32 + fq * 8;
      gpre[bj] = *(const u32x4v_t*)(d.gate + (size_t)row_ * NPROJ + col_);
      if (MODE == 3) { const float* mp_ = d.aux + (size_t)row_ * DM + col_; tpre[bj][0] = *(const f32x4*)mp_; tpre[bj][1] = *(const f32x4*)(mp_ + 4); }
    }
  };
  if (MODE == 2 || MODE == 3) ld_group(0, 0);
#pragma unroll
  for (int ai = 0; ai < 2; ++ai)
#pragma unroll
    for (int m = 0; m < 4; ++m) {
      const int row = brow + ai * HALF + wr * 64 + m * 16 + fr;
      u32x4v_t gcur[2]; f32x4 tcur[2][2];
      if (MODE == 2 || MODE == 3) {
        gcur[0] = gpre[0]; gcur[1] = gpre[1];
        if (MODE == 3) { tcur[0][0] = tpre[0][0]; tcur[0][1] = tpre[0][1]; tcur[1][0] = tpre[1][0]; tcur[1][1] = tpre[1][1]; }
        if (!(ai == 1 && m == 3)) ld_group(m == 3 ? ai + 1 : ai, m == 3 ? 0 : m + 1);
      }
      const int colb = bcol + wc * 32 + fq * 4;
      float ssq = 0.f;
#pragma unroll
      for (int bj = 0; bj < 2; ++bj) {
        const int col = bcol + bj * HALF + wc * 32 + fq * 8;
        const f32x4 v0 = acc[ai][bj][m][0], v1 = acc[ai][bj][m][1];
        if (MODE == 0) {
          u32x4v_t pk; pk[0] = pack2(v0[0], v0[1]); pk[1] = pack2(v0[2], v0[3]); pk[2] = pack2(v1[0], v1[1]); pk[3] = pack2(v1[2], v1[3]);
          *(u32x4v_t*)((bf16_t*)d.O + (size_t)row * d.ldo + col) = pk;
          if (d.aux != nullptr && col >= 10240) { *(f32x4*)(d.aux + (size_t)row * 512 + (col - 10240)) = v0; *(f32x4*)(d.aux + (size_t)row * 512 + (col - 10240) + 4) = v1; }
        } else if (MODE == 4) {
          u32x4v_t pk; pk[0] = pack2(v0[0], v0[1]); pk[1] = pack2(v0[2], v0[3]); pk[2] = pack2(v1[0], v1[1]); pk[3] = pack2(v1[2], v1[3]);
          *(u32x4v_t*)((bf16_t*)d.O + (size_t)row * d.ldo + col) = pk;
        } else if (MODE == 1) {
          u32x4v_t pk; pk[0] = pack2(v0[0], v0[1]); pk[1] = pack2(v0[2], v0[3]); pk[2] = pack2(v1[0], v1[1]); pk[3] = pack2(v1[2], v1[3]);
          *(u32x4v_t*)((bf16_t*)d.O + (size_t)row * d.ldo + col) = pk;
          ssq += (v0[0] * v0[0] + v0[1] * v0[1] + v0[2] * v0[2] + v0[3] * v0[3]) + (v1[0] * v1[0] + v1[1] * v1[1] + v1[2] * v1[2] + v1[3] * v1[3]);
        } else {
          const u32x4v_t g = gcur[bj];
          f32x4 s0, s1;
          s0[0] = sigmoidf_(lo2f(g[0])) * v0[0]; s0[1] = sigmoidf_(hi2f(g[0])) * v0[1]; s0[2] = sigmoidf_(lo2f(g[1])) * v0[2]; s0[3] = sigmoidf_(hi2f(g[1])) * v0[3];
          s1[0] = sigmoidf_(lo2f(g[2])) * v1[0]; s1[1] = sigmoidf_(hi2f(g[2])) * v1[1]; s1[2] = sigmoidf_(lo2f(g[3])) * v1[2]; s1[3] = sigmoidf_(hi2f(g[3])) * v1[3];
          float* mp = d.aux + (size_t)row * DM + col;
          if (MODE == 2) { *(f32x4*)mp = s0; *(f32x4*)(mp + 4) = s1; }
          else {
            const f32x4 t0 = tcur[bj][0], t1 = tcur[bj][1];
            u32x4v_t pk; pk[0] = pack2(t0[0] + s0[0], t0[1] + s0[1]); pk[1] = pack2(t0[2] + s0[2], t0[3] + s0[3]); pk[2] = pack2(t1[0] + s1[0], t1[1] + s1[1]); pk[3] = pack2(t1[2] + s1[2], t1[3] + s1[3]);
            *(u32x4v_t*)((bf16_t*)d.O + (size_t)row * d.ldo + col) = pk;
          }
        }
      }
      if (MODE == 1) {
        ssq += __shfl_xor(ssq, 16); ssq += __shfl_xor(ssq, 32);
        if (fq == 0) atomicAdd(d.ss + row, ssq);
      }
    }
  asm volatile("s_waitcnt vmcnt(0)" ::: "memory");
  __syncthreads();
}

template <int MODE>
DEVI void gemm_phase(const GD d, char* shm) {
  const int G = gridDim.x;
  const int c = (blockIdx.x + G - d.boff) % G;
  lds_u8* lds = (lds_u8*)shm;
  int pm, pn, npm = 0, npn = 0;
  bool have = tile_of((long)c, d.nM, d.nN, pm, pn), staged = false;
  for (int i = 0; have; ++i) {
    const bool has_next = tile_of((long)(i + 1) * G + c, d.nM, d.nN, npm, npn);
    gemm_tile<MODE>(d, pm, pn, lds, staged, has_next, npm, npn);
    staged = has_next; have = has_next; pm = npm; pn = npn;
  }
}

DEVI int perm32(int rho) { const int n = rho >> 4, i = rho & 15; return 8 * (i >> 2) + 4 * n + (i & 3); }

DEVI int srccol(int n, int mode) {
  if (mode == 0) return n;
  if (n < 3072) return n;
  if (n < 6144) return n + 8;
  if (n < 10240) return n + 296;
  if (n < 10528) return n - 4088;
  if (n < 10536) return n - 7456;
  return -1;
}
DEVI void conv_weight(const float* __restrict__ W, int ldw, int K, int N, bf16_t* __restrict__ Wt, int mode, int gw, int GW, int lane, const bool nts = false, const bool perm = false) {
  const int nkb = K / 64, ntask = (N / 64) * nkb;
  for (int t = gw; t < ntask; t += GW) {
    const int nb = t / nkb, kb = t % nkb;
    const int n = nb * 64 + lane; const int ns = perm ? ((n & ~31) + perm32(n & 31)) : n; const int sc = srccol(ns, mode);
    const float* src = W + (size_t)(kb * 64) * ldw + (sc < 0 ? 0 : sc);
    bf16_t* dst = Wt + (size_t)n * K + kb * 64;
#pragma unroll
    for (int j8 = 0; j8 < 8; ++j8) {
      float f[8];
#pragma unroll
      for (int j = 0; j < 8; ++j) f[j] = __builtin_nontemporal_load(src + (size_t)(j8 * 8 + j) * ldw);
      if (sc < 0) {
#pragma unroll
        for (int j = 0; j < 8; ++j) f[j] = 0.f;
      }
      u32x4v_t o; o[0] = pack2(f[0], f[1]); o[1] = pack2(f[2], f[3]); o[2] = pack2(f[4], f[5]); o[3] = pack2(f[6], f[7]);
      if (nts) __builtin_nontemporal_store(o, (u32x4v_t*)(dst + j8 * 8)); else *(u32x4v_t*)(dst + j8 * 8) = o;
    }
  }
}
DEVI void conv_weight_lds(const float* __restrict__ W, int ldw, int K, int N, bf16_t* __restrict__ Wt, int mode, int gw, int GW, int lane, float* scr, const bool nts) {
  const int nkb = K / 64, ntask = (N / 64) * nkb;
  for (int t = gw; t < ntask; t += GW) {
    const int nb = t / nkb, kb = t % nkb, n0 = nb * 64;
    const int sc = srccol(n0 + lane, mode);
    const float* src = W + (size_t)(kb * 64) * ldw + (sc < 0 ? 0 : sc);
#pragma unroll 16
    for (int j = 0; j < 64; ++j) { const float f = __builtin_nontemporal_load(src + (size_t)j * ldw); scr[j * 65 + lane] = (sc < 0) ? 0.f : f; }
    const int c = lane & 7, rsub = lane >> 3;
#pragma unroll
    for (int jj = 0; jj < 8; ++jj) {
      const int r = rsub + 8 * jj, cs = (r & ~31) + perm32(r & 31);
      const float* sp = scr + (8 * c) * 65 + cs;
      u32x4v_t o; o[0] = pack2(sp[0], sp[65]); o[1] = pack2(sp[2 * 65], sp[3 * 65]); o[2] = pack2(sp[4 * 65], sp[5 * 65]); o[3] = pack2(sp[6 * 65], sp[7 * 65]);
      bf16_t* dp = Wt + (size_t)(n0 + r) * K + kb * 64 + 8 * c;
      if (nts) __builtin_nontemporal_store(o, (u32x4v_t*)dp); else *(u32x4v_t*)dp = o;
    }
  }
}
DEVI void conv_task64(const float* __restrict__ W, int ldw, int K, bf16_t* __restrict__ Wt, int t, int lane) {
  const int nkb = K / 64, nb = t / nkb, kb = t % nkb, n = nb * 64 + lane;
  const float* src = W + (size_t)(kb * 64) * ldw + ((n & ~31) + perm32(n & 31));
  bf16_t* dst = Wt + (size_t)n * K + kb * 64;
#pragma unroll
  for (int j8 = 0; j8 < 8; ++j8) {
    float f[8];
#pragma unroll
    for (int j = 0; j < 8; ++j) f[j] = __builtin_nontemporal_load(src + (size_t)(j8 * 8 + j) * ldw);
    uint4 o; o.x = pack2(f[0], f[1]); o.y = pack2(f[2], f[3]); o.z = pack2(f[4], f[5]); o.w = pack2(f[6], f[7]);
    *(uint4*)(dst + j8 * 8) = o;
  }
}
DEVI void late_conv_task(const Params& p, int t, int lane) {
  char* ws = p.ws;
  if (t < 512) conv_task64(p.in[18], 2048, 1024, (bf16_t*)(ws + O_WA), t, lane);
  else if (t < 1024) conv_task64(p.in[19], 2048, 1024, (bf16_t*)(ws + O_WB), t - 512, lane);
  else if (t < 2048) conv_task64(p.in[20], 2048, 2048, (bf16_t*)(ws + O_WOUT), t - 1024, lane);
  else if (t < 2304) conv_task64(p.in[24], 512, 2048, (bf16_t*)(ws + O_WQ), t - 2048, lane);
  else if (t < 2560) conv_task64(p.in[26], 2048, 512, (bf16_t*)(ws + O_WO), t - 2304, lane);
}
DEVI void rms_row_bf16(const float* __restrict__ xr, const float* __restrict__ g, bf16_t* __restrict__ o, int lane) {
  f32x4 v[8]; float s = 0.f;
#pragma unroll
  for (int i = 0; i < 8; ++i) { v[i] = __builtin_nontemporal_load((const f32x4*)(xr + 4 * (lane + 64 * i))); s += v[i][0] * v[i][0] + v[i][1] * v[i][1] + v[i][2] * v[i][2] + v[i][3] * v[i][3]; }
  const float r = rsqrtf(wave_sum(s) * (1.f / 2048.f) + 1e-6f);
#pragma unroll
  for (int i = 0; i < 8; ++i) {
    const f32x4 gg = *(const f32x4*)(g + 4 * (lane + 64 * i));
    uint2 pk; pk.x = pack2(v[i][0] * r * gg[0], v[i][1] * r * gg[1]); pk.y = pack2(v[i][2] * r * gg[2], v[i][3] * r * gg[3]);
    *(uint2*)(o + 4 * (lane + 64 * i)) = pk;
  }
}
template <bool XI16, bool XO16>
DEVI void resid_row(const void* __restrict__ xi_, const bf16_t* __restrict__ y, float ssv, const float* __restrict__ gpost, void* __restrict__ xo_,
                    const float* __restrict__ gpre, bf16_t* __restrict__ ho, int lane) {
  const float r1 = rsqrtf(ssv * (1.f / 2048.f) + 1e-6f);
  f32x4 v[8]; float s = 0.f;
#pragma unroll
  for (int i = 0; i < 8; ++i) {
    const int c = 4 * (lane + 64 * i);
    f32x4 a; const f32x4 gg = *(const f32x4*)(gpost + c);
    if (XI16) { const u32x2_t xb = __builtin_nontemporal_load((const u32x2_t*)((const bf16_t*)xi_ + c)); a[0] = lo2f(xb[0]); a[1] = hi2f(xb[0]); a[2] = lo2f(xb[1]); a[3] = hi2f(xb[1]); }
    else a = __builtin_nontemporal_load((const f32x4*)((const float*)xi_ + c));
    const uint2 yb = *(const uint2*)(y + c);
    f32x4 b; b[0] = lo2f(yb.x); b[1] = hi2f(yb.x); b[2] = lo2f(yb.y); b[3] = hi2f(yb.y);
#pragma unroll
    for (int j = 0; j < 4; ++j) v[i][j] = a[j] + b[j] * r1 * gg[j];
    s += v[i][0] * v[i][0] + v[i][1] * v[i][1] + v[i][2] * v[i][2] + v[i][3] * v[i][3];
  }
#pragma unroll
  for (int i = 0; i < 8; ++i) {
    const int c = 4 * (lane + 64 * i);
    if (XO16) { u32x2_t ob; ob[0] = pack2(v[i][0], v[i][1]); ob[1] = pack2(v[i][2], v[i][3]); __builtin_nontemporal_store(ob, (u32x2_t*)((bf16_t*)xo_ + c)); }
    else __builtin_nontemporal_store(v[i], (f32x4*)((float*)xo_ + c));
  }
  if (ho != nullptr) {
    const float r = rsqrtf(wave_sum(s) * (1.f / 2048.f) + 1e-6f);
#pragma unroll
    for (int i = 0; i < 8; ++i) {
      const int c = 4 * (lane + 64 * i);
      const f32x4 gg = *(const f32x4*)(gpre + c);
      uint2 pk; pk.x = pack2(v[i][0] * r * gg[0], v[i][1] * r * gg[1]); pk.y = pack2(v[i][2] * r * gg[2], v[i][3] * r * gg[3]);
      *(uint2*)(ho + c) = pk;
    }
  }
}

DEVI void rwkv_prep_tile(const Params& p, int tile, char* shm) {
  const int tid = fresh_tid(), wid = tid >> 6, lane = tid & 63, fr = lane & 15, fq = lane >> 4;
  char* ws = p.ws;
  const float* tail = (const float*)(ws + O_TAIL);
  const bf16_t* proj = (const bf16_t*)(ws + O_PROJ);
  const float* mu = p.in[7];
  const int t0 = tile * 32;
  bf16_t* actW = (bf16_t*)shm;
  bf16_t* actA = actW + 32 * 72;
  bf16_t* actG = actA + 32 * 72;
  bf16_t* aS   = actG + 32 * 168;
  bf16x8 bfa[2][8];
  {
    const bf16_t* aupT_ = (const bf16_t*)(ws + O_WLR) + 1024 * 64;
#pragma unroll
    for (int ks = 0; ks < 2; ++ks)
#pragma unroll
      for (int n = 0; n < 8; ++n) bfa[ks][n] = *(const bf16x8*)(aupT_ + (size_t)(wid * 128 + n * 16 + fr) * 64 + ks * 32 + fq * 8);
  }
  for (int e = tid; e < 32 * 288; e += 512) {
    const int tt = e / 288, c = e % 288, t = t0 + tt;
    const float pc = tail[(size_t)t * 512 + c];
    const float pp = ((t % SEQ) > 0) ? tail[(size_t)(t - 1) * 512 + c] : 0.f;
    const float v = pc + (pp - pc) * mu[3072 + c];
    if (c < 64) actW[tt * 72 + c] = f2bf(tanhf(v));
    else if (c < 128) actA[tt * 72 + (c - 64)] = f2bf(v);
    else actG[tt * 168 + (c - 128)] = f2bf(sigmoidf_(v));
  }
  __syncthreads();
  const bf16_t* wupT = (const bf16_t*)(ws + O_WLR);
  const bf16_t* aupT = wupT + 1024 * 64;
  const bf16_t* gupT = aupT + 1024 * 64;
  const int ch0 = wid * 128;
  {
    f32x4 acc[2][8];
#pragma unroll
    for (int m = 0; m < 2; ++m)
#pragma unroll
      for (int n = 0; n < 8; ++n) acc[m][n] = (f32x4){0.f, 0.f, 0.f, 0.f};
#pragma unroll
    for (int ks = 0; ks < 2; ++ks) {
      bf16x8 af[2];
#pragma unroll
      for (int m = 0; m < 2; ++m) af[m] = *(const bf16x8*)(actA + (m * 16 + fr) * 72 + ks * 32 + fq * 8);
#pragma unroll
      for (int n = 0; n < 8; ++n) {
#pragma unroll
        for (int m = 0; m < 2; ++m) acc[m][n] = MFMA16(af[m], bfa[ks][n], acc[m][n]);
      }
    }
    const float* a0 = p.in[10];
#pragma unroll
    for (int n = 0; n < 8; ++n) {
      const int ch = ch0 + n * 16 + fr; const float a0v = a0[ch];
#pragma unroll
      for (int m = 0; m < 2; ++m)
#pragma unroll
        for (int j = 0; j < 4; ++j) aS[(m * 16 + fq * 4 + j) * 1032 + ch] = f2bf(sigmoidf_(a0v + acc[m][n][j]));
    }
  }
  {
    f32x4 acc[2][8];
#pragma unroll
    for (int m = 0; m < 2; ++m)
#pragma unroll
      for (int n = 0; n < 8; ++n) acc[m][n] = (f32x4){0.f, 0.f, 0.f, 0.f};
#pragma unroll
    for (int ks = 0; ks < 2; ++ks) {
      bf16x8 af[2];
#pragma unroll
      for (int m = 0; m < 2; ++m) af[m] = *(const bf16x8*)(actW + (m * 16 + fr) * 72 + ks * 32 + fq * 8);
#pragma unroll
      for (int n = 0; n < 8; ++n) {
        const bf16x8 bfr = *(const bf16x8*)(wupT + (size_t)(ch0 + (n >> 1) * 32 + perm32((n & 1) * 16 + fr)) * 64 + ks * 32 + fq * 8);
#pragma unroll
        for (int m = 0; m < 2; ++m) acc[m][n] = MFMA16(bfr, af[m], acc[m][n]);
      }
    }
    const float* w0 = p.in[8];
    float* RW = (float*)(ws + O_RW);
#pragma unroll
    for (int gq = 0; gq < 4; ++gq) {
      const int chb = ch0 + gq * 32 + fq * 8;
      const f32x4 w0a = *(const f32x4*)(w0 + chb), w0b = *(const f32x4*)(w0 + chb + 4);
#pragma unroll
      for (int m = 0; m < 2; ++m) {
        f32x4 oa, ob;
#pragma unroll
        for (int j = 0; j < 4; ++j) {
          const float za = -(w0a[j] + acc[m][2 * gq][j]), zb = -(w0b[j] + acc[m][2 * gq + 1][j]);
          const float spa = fmaxf(za, 0.f) + log1pf(__expf(-fabsf(za))), spb = fmaxf(zb, 0.f) + log1pf(__expf(-fabsf(zb)));
          oa[j] = __expf(-__expf(-spa - 0.5f)); ob[j] = __expf(-__expf(-spb - 0.5f));
        }
        float* dp = RW + (size_t)(t0 + m * 16 + fr) * 1024 + chb;
        *(f32x4*)dp = oa; *(f32x4*)(dp + 4) = ob;
      }
    }
  }
  {
    f32x4 acc[2][8];
#pragma unroll
    for (int m = 0; m < 2; ++m)
#pragma unroll
      for (int n = 0; n < 8; ++n) acc[m][n] = (f32x4){0.f, 0.f, 0.f, 0.f};
#pragma unroll
    for (int ks = 0; ks < 5; ++ks) {
      bf16x8 af[2];
#pragma unroll
      for (int m = 0; m < 2; ++m) af[m] = *(const bf16x8*)(actG + (m * 16 + fr) * 168 + ks * 32 + fq * 8);
#pragma unroll
      for (int n = 0; n < 8; ++n) {
        const bf16x8 bfr = *(const bf16x8*)(gupT + (size_t)(ch0 + (n >> 1) * 32 + perm32((n & 1) * 16 + fr)) * 160 + ks * 32 + fq * 8);
#pragma unroll
        for (int m = 0; m < 2; ++m) acc[m][n] = MFMA16(bfr, af[m], acc[m][n]);
      }
    }
    bf16_t* RG = (bf16_t*)(ws + O_RG);
#pragma unroll
    for (int gq = 0; gq < 4; ++gq)
#pragma unroll
      for (int m = 0; m < 2; ++m) {
        const f32x4 v0 = acc[m][2 * gq], v1 = acc[m][2 * gq + 1];
        u32x4v_t pk; pk[0] = pack2(v0[0], v0[1]); pk[1] = pack2(v0[2], v0[3]); pk[2] = pack2(v1[0], v1[1]); pk[3] = pack2(v1[2], v1[3]);
        *(u32x4v_t*)(RG + (size_t)(t0 + m * 16 + fr) * 1024 + ch0 + gq * 32 + fq * 8) = pk;
      }
  }
  __syncthreads();
  {
    bf16_t* RR = (bf16_t*)(ws + O_RR); bf16_t* RK = (bf16_t*)(ws + O_RK); bf16_t* RV = (bf16_t*)(ws + O_RV);
    bf16_t* RKK = (bf16_t*)(ws + O_RKK); bf16_t* RKA = (bf16_t*)(ws + O_RKA);
    const float* k_k = p.in[13]; const float* k_a = p.in[14];
#pragma unroll 1
    for (int hsel = 0; hsel < 2; ++hsel) {
      const int hh = wid + 8 * hsel, ch = hh * 64 + lane;
      const float mur = mu[ch], muk = mu[1024 + ch], muv = mu[2048 + ch], kkc = k_k[ch], kac = k_a[ch];
      const bf16_t* pc0 = proj + (size_t)t0 * NPROJ + 3072 + ch;
      float rp = 0.f, kp = 0.f, vp = 0.f;
      if ((t0 % SEQ) > 0) { rp = bf2f(*(pc0 - NPROJ)); kp = bf2f(*(pc0 - NPROJ + 1024)); vp = bf2f(*(pc0 - NPROJ + 2048)); }
#pragma unroll 1
      for (int tb = 0; tb < 32; tb += 4) {
        float rc[4], kc[4], vc[4], av[4];
#pragma unroll
        for (int j = 0; j < 4; ++j) {
          const bf16_t* pc = pc0 + (size_t)(tb + j) * NPROJ;
          rc[j] = bf2f(pc[0]); kc[j] = bf2f(pc[1024]); vc[j] = bf2f(pc[2048]); av[j] = bf2f(aS[(tb + j) * 1032 + ch]);
        }
#pragma unroll
        for (int j = 0; j < 4; ++j) {
          const float r = rc[j] + (rp - rc[j]) * mur, k = kc[j] + (kp - kc[j]) * muk, v = vc[j] + (vp - vc[j]) * muv, a = av[j];
          float kk = k * kkc;
          const float nrm = sqrtf(wave_sum_fast(kk * kk));
          kk = kk / fmaxf(nrm, 1e-12f);
          const float k2 = k * (1.f + (a - 1.f) * kac);
          const size_t o = (size_t)(t0 + tb + j) * 1024 + ch;
          RR[o] = f2bf(r); RK[o] = f2bf(k2); RV[o] = f2bf(v); RKK[o] = f2bf(kk); RKA[o] = f2bf(kk * a);
          rp = rc[j]; kp = kc[j]; vp = vc[j];
        }
      }
    }
  }
  __syncthreads();
}

DEVI float softcap15(float x) { const float z = x * (1.f / 15.f); return 15.f * (1.f - 2.f / (1.f + expf(2.f * z))); }

DEVI int invperm32(int d) { return 16 * ((d >> 2) & 1) + 4 * (d >> 3) + (d & 3); }
DEVI void stage_T64(const bf16_t* __restrict__ src, int ncol, bf16_t* dst, const float* sc, int tid, const bool perm = false) {
  for (int e = tid; e < 64 * ncol / 8; e += 512) {
    const int s = e & 63, cg8 = e >> 6;
    const uint4 v = *(const uint4*)(src + (size_t)s * NPROJ + cg8 * 8);
    const float f = sc ? sc[s] : 1.f;
    bf16_t* dp = dst + (perm ? ((cg8 >> 2) * 32 + (cg8 & 3) * 4) : (cg8 * 8)) * 72 + s;
    const int hi = perm ? 16 * 72 : 4 * 72;
    dp[0 * 72] = f2bf(lo2f(v.x) * f); dp[1 * 72] = f2bf(hi2f(v.x) * f); dp[2 * 72] = f2bf(lo2f(v.y) * f); dp[3 * 72] = f2bf(hi2f(v.y) * f);
    dp[hi + 0 * 72] = f2bf(lo2f(v.z) * f); dp[hi + 1 * 72] = f2bf(hi2f(v.z) * f); dp[hi + 2 * 72] = f2bf(lo2f(v.w) * f); dp[hi + 3 * 72] = f2bf(hi2f(v.w) * f);
  }
}

DEVI void mlstm_A(const Params& p, int task, char* shm) {
  const int tid = fresh_tid(), wid = tid >> 6, lane = tid & 63, fr = lane & 15, fq = lane >> 4;
  char* ws = p.ws;
  const int bh = task >> 6, c = task & 63, b = bh >> 2, h = bh & 3, t0 = b * SEQ + c * 64;
  const float* tail = (const float*)(ws + O_TAIL);
  const bf16_t* proj = (const bf16_t*)(ws + O_PROJ);
  bf16_t* vT = (bf16_t*)shm;
  bf16_t* kT = vT + 256 * 72;
  float* wsS = (float*)(kT + 128 * 72);
  uint4 vreg[4];
#pragma unroll
  for (int i = 0; i < 4; ++i) { const int e = tid + 512 * i; vreg[i] = *(const uint4*)(proj + (size_t)(t0 + (e & 63)) * NPROJ + 1024 + h * 256 + (e >> 6) * 8); }
  stage_T64(proj + (size_t)t0 * NPROJ + 512 + h * 128, 128, kT, nullptr, tid, true);
  if (wid == 0) {
    const int t = t0 + lane;
    const float ipre = tail[(size_t)t * 512 + 288 + h] + p.in[4][h];
    const float fpre = tail[(size_t)t * 512 + 292 + h] + p.in[5][h];
    const float ig = softcap15(ipre);
    const float fs = softcap15(fpre);
    const float logf = -(fmaxf(-fs, 0.f) + log1pf(expf(-fabsf(fs))));
    float bc = logf;
#pragma unroll
    for (int o = 1; o < 64; o <<= 1) { const float u = __shfl_up(bc, o); if (lane >= o) bc += u; }
    const float bL = __shfl(bc, 63);
    const float gs = bL - bc + ig;
    const float gm = wave_max(gs);
    wsS[lane] = expf(gs - gm);
    ((float*)(ws + O_BCUM))[(size_t)t * 4 + h] = bc;
    ((float*)(ws + O_IG))[(size_t)t * 4 + h] = ig;
    if (lane == 0) { ((float*)(ws + O_GMAX))[task] = gm; ((float*)(ws + O_BL))[task] = bL; }
  }
  __syncthreads();
#pragma unroll
  for (int i = 0; i < 4; ++i) {
    const int e = tid + 512 * i, s_ = e & 63, cg8 = e >> 6; const uint4 v = vreg[i]; const float f = wsS[s_];
    bf16_t* dp = vT + (cg8 * 8) * 72 + s_;
    dp[0 * 72] = f2bf(lo2f(v.x) * f); dp[1 * 72] = f2bf(hi2f(v.x) * f); dp[2 * 72] = f2bf(lo2f(v.y) * f); dp[3 * 72] = f2bf(hi2f(v.y) * f);
    dp[4 * 72] = f2bf(lo2f(v.z) * f); dp[5 * 72] = f2bf(hi2f(v.z) * f); dp[6 * 72] = f2bf(lo2f(v.w) * f); dp[7 * 72] = f2bf(hi2f(v.w) * f);
  }
  __syncthreads();
  {
    f32x4 acc[2][8];
#pragma unroll
    for (int m = 0; m < 2; ++m)
#pragma unroll
      for (int n = 0; n < 8; ++n) acc[m][n] = (f32x4){0.f, 0.f, 0.f, 0.f};
#pragma unroll
    for (int ks = 0; ks < 2; ++ks) {
      bf16x8 af[2];
#pragma unroll
      for (int m = 0; m < 2; ++m) af[m] = *(const bf16x8*)(vT + (wid * 32 + m * 16 + fr) * 72 + ks * 32 + fq * 8);
#pragma unroll
      for (int n = 0; n < 8; ++n) {
        const bf16x8 bfr = *(const bf16x8*)(kT + (n * 16 + fr) * 72 + ks * 32 + fq * 8);
#pragma unroll
        for (int m = 0; m < 2; ++m) acc[m][n] = MFMA16(bfr, af[m], acc[m][n]);
      }
    }
    bf16_t* dC = (bf16_t*)(ws + O_DC) + (size_t)task * 32768;
#pragma unroll
    for (int m = 0; m < 2; ++m)
#pragma unroll
      for (int gq = 0; gq < 4; ++gq) {
        bf16_t* dp = dC + (wid * 32 + m * 16 + fr) * 128 + gq * 32 + fq * 8;
        const f32x4 v0 = acc[m][2 * gq], v1 = acc[m][2 * gq + 1];
        u32x4v_t pk; pk[0] = pack2(v0[0], v0[1]); pk[1] = pack2(v0[2], v0[3]); pk[2] = pack2(v1[0], v1[1]); pk[3] = pack2(v1[2], v1[3]);
        __builtin_nontemporal_store(pk, (u32x4v_t*)dp);
      }
  }
  if (tid < 128) {
    float s = 0.f;
    const int krow = (tid & ~31) + invperm32(tid & 31);
    for (int i = 0; i < 64; ++i) s += wsS[i] * bf2f(kT[krow * 72 + i]);
    ((float*)(ws + O_DN))[(size_t)task * 128 + tid] = s;
  }
  __syncthreads();
}

DEVI void mlstm_scan(const Params& p, int mt, int MT) {
  char* ws = p.ws;
  const float* bLb = (const float*)(ws + O_BL); const float* gmb = (const float*)(ws + O_GMAX);
  for (int g = mt; g < 65536 + 1024; g += MT) {
    if (g < 65536) {
      const int bh = g >> 13, e4 = g & 8191;
      float m = 0.f; f32x4 C = (f32x4){0.f, 0.f, 0.f, 0.f};
      for (int c = 0; c < 64; ++c) {
        const int idx = bh * 64 + c;
        uint2 pk; pk.x = pack2(C[0], C[1]); pk.y = pack2(C[2], C[3]);
        *(uint2*)((bf16_t*)(ws + O_CST) + (size_t)idx * 32768 + e4 * 4) = pk;
        if (e4 == 0) ((float*)(ws + O_MST))[idx] = m;
        const float bL = bLb[idx], gm = gmb[idx];
        const float mn = fmaxf(bL + m, gm), cw = expf(bL + m - mn), lw = expf(gm - mn);
        const u32x2_t db = *(const u32x2_t*)((const bf16_t*)(ws + O_DC) + (size_t)idx * 32768 + e4 * 4);
        f32x4 dd; dd[0] = lo2f(db[0]); dd[1] = hi2f(db[0]); dd[2] = lo2f(db[1]); dd[3] = hi2f(db[1]);
        C = cw * C + lw * dd; m = mn;
      }
    } else {
      const int q = g - 65536, bh = q >> 7, dk = q & 127;
      float m = 0.f, n = 0.f;
      for (int c = 0; c < 64; ++c) {
        const int idx = bh * 64 + c;
        ((float*)(ws + O_NST))[(size_t)idx * 128 + dk] = n;
        const float bL = bLb[idx], gm = gmb[idx];
        const float mn = fmaxf(bL + m, gm), cw = expf(bL + m - mn), lw = expf(gm - mn);
        n = cw * n + lw * ((const float*)(ws + O_DN))[(size_t)idx * 128 + dk]; m = mn;
      }
    }
  }
}

DEVI void mlstm_D(const Params& p, int task, char* shm) {
  const int tid = fresh_tid(), wid = tid >> 6, lane = tid & 63, fr = lane & 15, fq = lane >> 4;
  char* ws = p.ws;
  const int bh = task >> 6, c = task & 63, b = bh >> 2, h = bh & 3, t0 = b * SEQ + c * 64;
  const bf16_t* proj = (const bf16_t*)(ws + O_PROJ);
  bf16_t* qS = (bf16_t*)shm;
  bf16_t* kS = qS + 64 * 136;
  bf16_t* vT = kS + 64 * 136;
  bf16_t* PS = vT + 256 * 72;
  float* fS = (float*)(PS + 64 * 72);
  float* bS = fS, *igS = fS + 64, *mtS = fS + 128, *wiS = fS + 192, *rdS = fS + 256, *nqS = fS + 320, *hsq = fS + 384, *nsS = fS + 448;
  const float scale = 0.08838834764831845f;
  const float m_s = ((const float*)(ws + O_MST))[task];
  float og[4][4][2];
#pragma unroll
  for (int m = 0; m < 4; ++m)
#pragma unroll
    for (int j = 0; j < 4; ++j)
#pragma unroll
      for (int n = 0; n < 2; ++n) og[m][j][n] = bf2f(proj[(size_t)(t0 + m * 16 + fq * 4 + j) * NPROJ + 2048 + h * 256 + wid * 32 + n * 16 + fr]);
  bf16x8 cfr[4][2];
  {
    const bf16_t* Cst0 = (const bf16_t*)(ws + O_CST) + (size_t)task * 32768;
#pragma unroll
    for (int ks = 0; ks < 4; ++ks)
#pragma unroll
      for (int n = 0; n < 2; ++n) cfr[ks][n] = *(const bf16x8*)(Cst0 + (size_t)(wid * 32 + n * 16 + fr) * 128 + ks * 32 + fq * 8);
  }
  if (tid < 64) { bS[tid] = ((const float*)(ws + O_BCUM))[(size_t)(t0 + tid) * 4 + h]; igS[tid] = ((const float*)(ws + O_IG))[(size_t)(t0 + tid) * 4 + h]; hsq[tid] = 0.f; }
  else if (tid < 192) nsS[tid - 64] = ((const float*)(ws + O_NST))[(size_t)task * 128 + (tid - 64)];
  for (int e = tid; e < 1024; e += 512) {
    const int s = e >> 4, c8 = e & 15;
    *(uint4*)(qS + s * 136 + c8 * 8) = *(const uint4*)(proj + (size_t)(t0 + s) * NPROJ + h * 128 + c8 * 8);
    *(uint4*)(kS + s * 136 + c8 * 8) = *(const uint4*)(proj + (size_t)(t0 + s) * NPROJ + 512 + h * 128 + c8 * 8);
  }
  stage_T64(proj + (size_t)t0 * NPROJ + 1024 + h * 256, 256, vT, nullptr, tid);
  __syncthreads();
  if (tid < 64) {
    float am = -INFINITY;
    for (int s = 0; s <= tid; ++s) am = fmaxf(am, igS[s] - bS[s]);
    const float mt_ = bS[tid] + fmaxf(m_s, am);
    mtS[tid] = mt_; wiS[tid] = expf(bS[tid] + m_s - mt_) * scale;
  } else if (tid < 128) {
    const int t = tid - 64; float s = 0.f;
    for (int i = 0; i < 128; ++i) s += nsS[i] * bf2f(qS[t * 136 + i]);
    nqS[t] = s;
  }
  f32x4 sacc[2];
  const int mt_i = wid >> 1, nt0 = (wid & 1) * 2;
  {
    sacc[0] = (f32x4){0.f, 0.f, 0.f, 0.f}; sacc[1] = sacc[0];
#pragma unroll
    for (int ks = 0; ks < 4; ++ks) {
      const bf16x8 af = *(const bf16x8*)(qS + (mt_i * 16 + fr) * 136 + ks * 32 + fq * 8);
#pragma unroll
      for (int n = 0; n < 2; ++n) {
        const bf16x8 bfr = *(const bf16x8*)(kS + ((nt0 + n) * 16 + fr) * 136 + ks * 32 + fq * 8);
        sacc[n] = MFMA16(af, bfr, sacc[n]);
      }
    }
  }
  __syncthreads();
#pragma unroll
  for (int n = 0; n < 2; ++n) {
    const int s = (nt0 + n) * 16 + fr;
#pragma unroll
    for (int j = 0; j < 4; ++j) {
      const int t = mt_i * 16 + fq * 4 + j;
      float pv = 0.f;
      if (s <= t) pv = sacc[n][j] * scale * expf(bS[t] - bS[s] + igS[s] - mtS[t]);
      PS[t * 72 + s] = f2bf(pv);
    }
  }
  __syncthreads();
  if (tid < 64) {
    float rs = 0.f;
    for (int s = 0; s < 64; ++s) rs += bf2f(PS[tid * 72 + s]);
    const float den = wiS[tid] * nqS[tid] + rs;
    rdS[tid] = 1.f / fmaxf(fabsf(den), expf(-mtS[tid]));
  }
  f32x4 acc[4][2];
#pragma unroll
  for (int m = 0; m < 4; ++m) { acc[m][0] = (f32x4){0.f, 0.f, 0.f, 0.f}; acc[m][1] = acc[m][0]; }
  {
#pragma unroll
    for (int ks = 0; ks < 4; ++ks) {
#pragma unroll
      for (int m = 0; m < 4; ++m) {
        const bf16x8 af = *(const bf16x8*)(qS + (m * 16 + fr) * 136 + ks * 32 + fq * 8);
#pragma unroll
        for (int n = 0; n < 2; ++n) acc[m][n] = MFMA16(af, cfr[ks][n], acc[m][n]);
      }
    }
#pragma unroll
    for (int m = 0; m < 4; ++m)
#pragma unroll
      for (int j = 0; j < 4; ++j) { const float w = wiS[m * 16 + fq * 4 + j]; acc[m][0][j] *= w; acc[m][1][j] *= w; }
#pragma unroll
    for (int ks = 0; ks < 2; ++ks) {
      bf16x8 bfr[2];
#pragma unroll
      for (int n = 0; n < 2; ++n) bfr[n] = *(const bf16x8*)(vT + (wid * 32 + n * 16 + fr) * 72 + ks * 32 + fq * 8);
#pragma unroll
      for (int m = 0; m < 4; ++m) {
        const bf16x8 af = *(const bf16x8*)(PS + (m * 16 + fr) * 72 + ks * 32 + fq * 8);
#pragma unroll
        for (int n = 0; n < 2; ++n) acc[m][n] = MFMA16(af, bfr[n], acc[m][n]);
      }
    }
  }
  __syncthreads();
#pragma unroll
  for (int m = 0; m < 4; ++m)
#pragma unroll
    for (int j = 0; j < 4; ++j) {
      const int t = m * 16 + fq * 4 + j; const float rd = rdS[t];
      acc[m][0][j] *= rd; acc[m][1][j] *= rd;
      float sq = acc[m][0][j] * acc[m][0][j] + acc[m][1][j] * acc[m][1][j];
      sq = sum16(sq);
      if (fr == 0) atomicAdd(&hsq[t], sq);
    }
  __syncthreads();
  {
    const float* hn = p.in[6];
    const float hn0 = hn[h * 256 + wid * 32 + fr], hn1 = hn[h * 256 + wid * 32 + 16 + fr];
    bf16_t* HA = (bf16_t*)(ws + O_HA);
#pragma unroll
    for (int m = 0; m < 4; ++m)
#pragma unroll
      for (int j = 0; j < 4; ++j) {
        const int t = m * 16 + fq * 4 + j; const float rn = rsqrtf(hsq[t] * (1.f / 256.f) + 1e-6f);
#pragma unroll
        for (int n = 0; n < 2; ++n) {
          const int dv = h * 256 + wid * 32 + n * 16 + fr;
          const float o = og[m][j][n];
          HA[(size_t)(t0 + t) * 1024 + dv] = f2bf(sigmoidf_(o) * acc[m][n][j] * rn * (n == 0 ? hn0 : hn1));
        }
      }
  }
  __syncthreads();
}

typedef float f32x2 __attribute__((ext_vector_type(2)));
DEVI float sum32(float x) {
  x = dpp_sum16(x);
  const unsigned a = __float_as_uint(x);
  const auto r = __builtin_amdgcn_permlane16_swap(a, a, false, false);
  return __uint_as_float(r[0]) + __uint_as_float(r[1]);
}
constexpr int SC_T = 32, SC_BUF = 41984;
constexpr int SC_PA = 0, SC_PB = 16384, SC_PC = 32768, SC_PV = 40960, SC_YP = 2 * SC_BUF, SC_YPSZ = 32768;
DEVI void scan_yreduce(const Params& p, const char* shm, int chunk, int q, int b, int h, int rowb) {
  const int s_ = q >> 3, r8 = q & 7;
  const float* yp = (const float*)(shm + SC_YP + (chunk & 1) * SC_YPSZ) + ((s_ * 4 + (r8 >> 1)) * 64 + (r8 & 1) * 32);
  f32x4 acc = (f32x4){0.f, 0.f, 0.f, 0.f};
#pragma unroll
  for (int jj = 0; jj < 8; ++jj) acc += *(const f32x4*)(yp + (((jj + q) & 7) * 4));
  ((float*)(p.ws + O_YS))[((size_t)b * SEQ + (size_t)chunk * SC_T + s_) * 1024 + h * 64 + rowb + r8] = (acc[0] + acc[1]) + (acc[2] + acc[3]);
}
struct ScanE { f32x2 w; unsigned kk, ka, k, r; };
DEVI void scan_ld1(ScanE& e, const char* ws, size_t o) {
  e.w = *(const f32x2*)((const float*)(ws + O_RW) + o); e.kk = *(const unsigned*)((const bf16_t*)(ws + O_RKK) + o); e.ka = *(const unsigned*)((const bf16_t*)(ws + O_RKA) + o);
  e.k = *(const unsigned*)((const bf16_t*)(ws + O_RK) + o); e.r = *(const unsigned*)((const bf16_t*)(ws + O_RR) + o);
}
DEVI void scan_st1(const ScanE& e, char* buf, int lE) {
  f32x4 ta, tb; ta[0] = e.w[0]; ta[1] = e.w[1]; ta[2] = lo2f(e.kk); ta[3] = hi2f(e.kk); tb[0] = lo2f(e.ka); tb[1] = hi2f(e.ka); tb[2] = lo2f(e.k); tb[3] = hi2f(e.k);
  *(f32x4*)(buf + SC_PA + lE * 16) = ta; *(f32x4*)(buf + SC_PB + lE * 16) = tb;
  *(f32x2*)(buf + SC_PC + lE * 8) = (f32x2){lo2f(e.r), hi2f(e.r)};
}
#define SCAN_LD(off) do { if (isH) { scan_ld1(E0, ws, gE + (off)); scan_ld1(E1, ws, gE + (off) + 8192); scan_ld1(E2, ws, gE + (off) + 16384); scan_ld1(E3, ws, gE + (off) + 24576); \
    Lv = ((const bf16_t*)(ws + O_RV))[gV + (off)]; } } while (0)
#define SCAN_ST(buf) do { if (isH) { scan_st1(E0, (buf), lE); scan_st1(E1, (buf), lE + 256); scan_st1(E2, (buf), lE + 512); scan_st1(E3, (buf), lE + 768); *(float*)((buf) + lV) = lo2f(Lv); } } while (0)
DEVI void scan_phase(const Params& p, char* shm) {
  const int tid = fresh_tid(), wid = tid >> 6, lane = tid & 63, blk = blockIdx.x;
  char* ws = p.ws;
  const int bh = blk >> 3, b = bh >> 4, h = bh & 15, rowb = (blk & 7) * 8;
  const bool isH = wid >= 4;
  const int hx = tid & 255;
  const size_t gE = ((size_t)b * SEQ + (hx >> 5)) * 1024 + h * 64 + (hx & 31) * 2;
  const size_t gV = ((size_t)b * SEQ + (hx >> 3)) * 1024 + h * 64 + rowb + (hx & 7);
  const int lE = hx, lV = SC_PV + hx * 4;
  const int g = blk * 256 + (tid - 256);
  const bool isC = (wid >= 4), isN = (isC && g < 1024);
  const int mbh = g >> 13, e4 = g & 8191, nbh = g >> 7, ndk = g & 127;
  float mm = 0.f, mn_ = 0.f, nn = 0.f; f32x4 C = (f32x4){0.f, 0.f, 0.f, 0.f}, dd = C; float dn = 0.f;
  const float* bLb = (const float*)(ws + O_BL); const float* gmb = (const float*)(ws + O_GMAX);
  if (isC) { const u32x2_t db = *(const u32x2_t*)((const bf16_t*)(ws + O_DC) + (size_t)(mbh * 64) * 32768 + e4 * 4); dd[0] = lo2f(db[0]); dd[1] = hi2f(db[0]); dd[2] = lo2f(db[1]); dd[3] = hi2f(db[1]); }
  float bLn = 0.f, gmn = 0.f;
  if (isC) { bLn = bLb[mbh * 64]; gmn = gmb[mbh * 64]; }
  if (isN) dn = ((const float*)(ws + O_DN))[(size_t)(nbh * 64) * 128 + ndk];
  const int rr = lane >> 5, cl = lane & 31, rowl = wid * 2 + rr;
  f32x2 st = (f32x2){0.f, 0.f};
  ScanE E0, E1, E2, E3; unsigned Lv = 0u;
  E0.w = E1.w = E2.w = E3.w = (f32x2){0.f, 0.f}; E0.kk = E0.ka = E0.k = E0.r = E1.kk = E1.ka = E1.k = E1.r = E2.kk = E2.ka = E2.k = E2.r = E3.kk = E3.ka = E3.k = E3.r = 0u;
  SCAN_LD((size_t)0);
  SCAN_ST(shm);
  SCAN_LD((size_t)SC_T * 1024);
  __syncthreads();
  for (int i = 0; i < SEQ / SC_T; ++i) {
    const bool more = (i + 1 < SEQ / SC_T);
    if (more) { char* nb = shm + ((i + 1) & 1) * SC_BUF; SCAN_ST(nb); }
    { const size_t adv = (size_t)(i + 2 < SEQ / SC_T ? i + 2 : i) * SC_T * 1024; SCAN_LD(adv); }
    if (wid < 4) {
      const char* buf = shm + (i & 1) * SC_BUF;
      float* yp = (float*)(shm + SC_YP + (i & 1) * SC_YPSZ) + wid * 64 + lane;
      const char* bA = buf + SC_PA + cl * 16; const char* bB = buf + SC_PB + cl * 16; const char* bC = buf + SC_PC + cl * 8;
      const char* bV = buf + SC_PV + rowl * 4;
      f32x4 a = *(const f32x4*)bA, bq = *(const f32x4*)bB; f32x2 r = *(const f32x2*)bC; float v = *(const float*)bV;
#pragma unroll 8
      for (int t = 0; t < SC_T; ++t) {
        const int tn = (t + 1 < SC_T) ? t + 1 : t;
        const f32x4 a2 = *(const f32x4*)(bA + tn * 512), b2 = *(const f32x4*)(bB + tn * 512);
        const f32x2 r2_ = *(const f32x2*)(bC + tn * 256); const float v2 = *(const float*)(bV + tn * 32);
        const f32x2 w = (f32x2){a[0], a[1]}, kk = (f32x2){a[2], a[3]}, ka = (f32x2){bq[0], bq[1]}, k = (f32x2){bq[2], bq[3]};
        const f32x2 pk = st * kk;
        const f32x2 tmp = st * w + v * k;
        const float sa = sum32(pk.x + pk.y);
        st = tmp - sa * ka;
        const f32x2 py = st * r;
        yp[t * 256] = py.x + py.y;
        a = a2; bq = b2; r = r2_; v = v2;
      }
    } else {
      if (i > 0) scan_yreduce(p, shm, i - 1, tid - 256, b, h, rowb);
      if (i == 9 || i == 49 || i == 89) { const int ct = blk * 4 + (wid - 4) + 1024 * (i / 40); if (ct < 2560) late_conv_task(p, ct, lane); }
    }
    if (wid >= 4 && (i & 1) == 0) {
      const int c = i >> 1, idx = mbh * 64 + c;
      {
        const float bL = bLn, gm = gmn;
        if (c < 63) { bLn = bLb[idx + 1]; gmn = gmb[idx + 1]; }
        const float mn = fmaxf(bL + mm, gm), cw = expf(bL + mm - mn), lw = expf(gm - mn);
        uint2 pk; pk.x = pack2(C[0], C[1]); pk.y = pack2(C[2], C[3]);
        *(uint2*)((bf16_t*)(ws + O_CST) + (size_t)idx * 32768 + e4 * 4) = pk;
        if (e4 == 0) ((float*)(ws + O_MST))[idx] = mm;
        C = cw * C + lw * dd;
        if (c < 63) { const u32x2_t db = __builtin_nontemporal_load((const u32x2_t*)((const bf16_t*)(ws + O_DC) + (size_t)(idx + 1) * 32768 + e4 * 4)); dd[0] = lo2f(db[0]); dd[1] = hi2f(db[0]); dd[2] = lo2f(db[1]); dd[3] = hi2f(db[1]); }
        mm = mn;
      }
      if (isN) {
        const int nidx = nbh * 64 + c;
        const float bL = bLb[nidx], gm = gmb[nidx];
        const float mn = fmaxf(bL + mn_, gm), cw = expf(bL + mn_ - mn), lw = expf(gm - mn);
        ((float*)(ws + O_NST))[(size_t)nidx * 128 + ndk] = nn;
        nn = cw * nn + lw * dn;
        if (c < 63) dn = ((const float*)(ws + O_DN))[(size_t)(nidx + 1) * 128 + ndk];
        mn_ = mn;
      }
    }
    __syncthreads();
  }
  if (wid >= 4) scan_yreduce(p, shm, SEQ / SC_T - 1, tid - 256, b, h, rowb);
  __syncthreads();
}

DEVI void rwkv_post(const Params& p, int gw, int GW, int lane) {
  char* ws = p.ws;
  const float* YS = (const float*)(ws + O_YS);
  const bf16_t* RR = (const bf16_t*)(ws + O_RR); const bf16_t* RK = (const bf16_t*)(ws + O_RK); const bf16_t* RV = (const bf16_t*)(ws + O_RV); const bf16_t* RG = (const bf16_t*)(ws + O_RG);
  bf16_t* HB = (bf16_t*)(ws + O_HB);
  const float* r_k = p.in[15]; const float* ln_g = p.in[16]; const float* ln_b = p.in[17];
#pragma unroll 1
  for (int pr0 = gw; pr0 < TOK * 16; pr0 += 4 * GW) {
    float y[4], r[4], k[4], v[4], g[4], prk[4], plg[4], plb[4]; size_t o[4]; int chs[4];
#pragma unroll
    for (int j = 0; j < 4; ++j) {
      const int pr = pr0 + j * GW; const int prc = pr < TOK * 16 ? pr : pr0;
      const int t = prc >> 4, hh = prc & 15; chs[j] = hh * 64 + lane; o[j] = (size_t)t * 1024 + chs[j];
      y[j] = __builtin_nontemporal_load(YS + o[j]); r[j] = bf2f(__builtin_nontemporal_load(RR + o[j])); k[j] = bf2f(__builtin_nontemporal_load(RK + o[j])); v[j] = bf2f(__builtin_nontemporal_load(RV + o[j])); g[j] = bf2f(__builtin_nontemporal_load(RG + o[j]));
      prk[j] = r_k[chs[j]]; plg[j] = ln_g[chs[j]]; plb[j] = ln_b[chs[j]];
    }
#pragma unroll
    for (int j = 0; j < 4; ++j) {
      const float mean = wave_sum_fast(y[j]) * (1.f / 64.f);
      const float dlt = y[j] - mean;
      const float var = wave_sum_fast(dlt * dlt) * (1.f / 64.f);
      const float bonus = wave_sum_fast(r[j] * k[j] * prk[j]);
      const float yn = dlt * rsqrtf(var + 64e-5f) * plg[j] + plb[j];
      if (pr0 + j * GW < TOK * 16) HB[o[j]] = f2bf((yn + bonus * v[j]) * g[j]);
    }
  }
}

DEVI void xattn_task(const Params& p, int task, char* shm) {
  const int tid = fresh_tid(), wid = tid >> 6, lane = tid & 63, fr = lane & 15, fq = lane >> 4;
  char* ws = p.ws;
  const int qt = task & 31, hd = (task >> 5) & 3, b = task >> 7;
  const bf16_t* KV = (const bf16_t*)(ws + O_KV); const bf16_t* Q = (const bf16_t*)(ws + O_Q); bf16_t* OO = (bf16_t*)(ws + O_O);
  bf16_t* VT = (bf16_t*)shm;
  bf16_t* Pw = VT + 128 * 264 + wid * (16 * 264);
  const int r0 = b * SEQ + qt * 128 + wid * 16;
  bf16x8 afq[4];
#pragma unroll
  for (int ks = 0; ks < 4; ++ks) {
    const bf16_t* qp = Q + (size_t)(r0 + fr) * 512 + hd * 128 + ks * 32 + fq * 8;
    f32x4 q0 = (f32x4){0.f, 0.f, 0.f, 0.f}, q1 = q0;
#pragma unroll
    for (int sp = 0; sp < 4; ++sp) {
      const u32x4v_t qb = *(const u32x4v_t*)(qp + (size_t)sp * (TOK * 512));
      q0[0] += lo2f(qb[0]); q0[1] += hi2f(qb[0]); q0[2] += lo2f(qb[1]); q0[3] += hi2f(qb[1]);
      q1[0] += lo2f(qb[2]); q1[1] += hi2f(qb[2]); q1[2] += lo2f(qb[3]); q1[3] += hi2f(qb[3]);
    }
    union { unsigned u[4]; bf16x8 v; } qa; qa.u[0] = pack2(q0[0], q0[1]); qa.u[1] = pack2(q0[2], q0[3]); qa.u[2] = pack2(q1[0], q1[1]); qa.u[3] = pack2(q1[2], q1[3]);
    afq[ks] = qa.v;
  }
  bf16x8 kf0[16];
#pragma unroll
  for (int n = 0; n < 16; ++n) kf0[n] = *(const bf16x8*)(KV + (size_t)(b * 256 + n * 16 + fr) * 1024 + hd * 128 + fq * 8);
  for (int e = tid; e < 4096; e += 512) {
    const int m = e & 255, dg = e >> 8;
    const uint4 v = *(const uint4*)(KV + (size_t)(b * 256 + m) * 1024 + 512 + hd * 128 + dg * 8);
    bf16_t* dp = VT + (dg * 8) * 264 + m;
    dp[0 * 264] = (bf16_t)(v.x & 0xffff); dp[1 * 264] = (bf16_t)(v.x >> 16); dp[2 * 264] = (bf16_t)(v.y & 0xffff); dp[3 * 264] = (bf16_t)(v.y >> 16);
    dp[4 * 264] = (bf16_t)(v.z & 0xffff); dp[5 * 264] = (bf16_t)(v.z >> 16); dp[6 * 264] = (bf16_t)(v.w & 0xffff); dp[7 * 264] = (bf16_t)(v.w >> 16);
  }
  __syncthreads();
  f32x4 sc[16];
#pragma unroll
  for (int n = 0; n < 16; ++n) sc[n] = (f32x4){0.f, 0.f, 0.f, 0.f};
#pragma unroll
  for (int ks = 0; ks < 4; ++ks) {
    const bf16x8 af = afq[ks];
#pragma unroll
    for (int n = 0; n < 16; ++n) {
      const bf16x8 bfr = (ks == 0) ? kf0[n] : *(const bf16x8*)(KV + (size_t)(b * 256 + n * 16 + fr) * 1024 + hd * 128 + ks * 32 + fq * 8);
      sc[n] = MFMA16(af, bfr, sc[n]);
    }
  }
  float rinv[4];
#pragma unroll
  for (int j = 0; j < 4; ++j) {
    float mx = -INFINITY;
#pragma unroll
    for (int n = 0; n < 16; ++n) mx = fmaxf(mx, sc[n][j]);
    mx = max16(mx) * 0.08838834764831845f;
    float sm = 0.f;
#pragma unroll
    for (int n = 0; n < 16; ++n) { const float e = __expf(sc[n][j] * 0.08838834764831845f - mx); sm += e; Pw[(fq * 4 + j) * 264 + n * 16 + fr] = f2bf(e); }
    rinv[j] = 1.f / sum16(sm);
  }
  __syncthreads();
  f32x4 oa[8];
#pragma unroll
  for (int n = 0; n < 8; ++n) oa[n] = (f32x4){0.f, 0.f, 0.f, 0.f};
#pragma unroll
  for (int ks = 0; ks < 8; ++ks) {
    const bf16x8 af = *(const bf16x8*)(Pw + fr * 264 + ks * 32 + fq * 8);
#pragma unroll
    for (int n = 0; n < 8; ++n) {
      const bf16x8 bfr = *(const bf16x8*)(VT + (n * 16 + fr) * 264 + ks * 32 + fq * 8);
      oa[n] = MFMA16(af, bfr, oa[n]);
    }
  }
#pragma unroll
  for (int n = 0; n < 8; ++n)
#pragma unroll
    for (int j = 0; j < 4; ++j) OO[(size_t)(r0 + fq * 4 + j) * 512 + hd * 128 + n * 16 + fr] = f2bf(oa[n][j] * rinv[j]);
  __syncthreads();
}

DEVI void conv_glu(const Params& p, int gt, int GT) {
  char* ws = p.ws;
  const bf16_t* U = (const bf16_t*)(ws + O_U); bf16_t* ACT = (bf16_t*)(ws + O_ACT);
  const float* cw = p.in[30]; const float* cb = p.in[31];
  for (int task = gt; task < 256 * 1024; task += GT) {
    const int jg = task & 1023, run = task >> 10, j0 = jg * 8, t0 = run * 32;
    float w[3][16], bb[16];
#pragma unroll
    for (int i = 0; i < 8; ++i) {
      bb[i] = cb[j0 + i]; bb[8 + i] = cb[8192 + j0 + i];
#pragma unroll
      for (int tp = 0; tp < 3; ++tp) { w[tp][i] = cw[tp * 16384 + j0 + i]; w[tp][8 + i] = cw[tp * 16384 + 8192 + j0 + i]; }
    }
    float p1[16], p2[16];
    auto ld16 = [&](int t, float* o) {
      typedef unsigned u32x4_t __attribute__((ext_vector_type(4)));
      const u32x4_t a_ = __builtin_nontemporal_load((const u32x4_t*)(U + (size_t)t * 16384 + j0)), c_ = __builtin_nontemporal_load((const u32x4_t*)(U + (size_t)t * 16384 + 8192 + j0));
      uint4 a, c; a.x = a_[0]; a.y = a_[1]; a.z = a_[2]; a.w = a_[3]; c.x = c_[0]; c.y = c_[1]; c.z = c_[2]; c.w = c_[3];
      o[0] = lo2f(a.x); o[1] = hi2f(a.x); o[2] = lo2f(a.y); o[3] = hi2f(a.y); o[4] = lo2f(a.z); o[5] = hi2f(a.z); o[6] = lo2f(a.w); o[7] = hi2f(a.w);
      o[8] = lo2f(c.x); o[9] = hi2f(c.x); o[10] = lo2f(c.y); o[11] = hi2f(c.y); o[12] = lo2f(c.z); o[13] = hi2f(c.z); o[14] = lo2f(c.w); o[15] = hi2f(c.w);
    };
    if ((t0 % SEQ) > 0) { ld16(t0 - 1, p1); ld16(t0 - 2, p2); }
    else {
#pragma unroll
      for (int i = 0; i < 16; ++i) { p1[i] = 0.f; p2[i] = 0.f; }
    }
#pragma unroll 1
    for (int tt = 0; tt < 32; tt += 4) {
      float c0[16], c1[16], c2[16], c3[16];
      ld16(t0 + tt, c0); ld16(t0 + tt + 1, c1); ld16(t0 + tt + 2, c2); ld16(t0 + tt + 3, c3);
      auto one = [&](const float* pp2, const float* pp1, const float* cur, int t) {
        float res[8];
#pragma unroll
        for (int i = 0; i < 8; ++i) {
          const float gt_ = bb[i] + w[0][i] * pp2[i] + w[1][i] * pp1[i] + w[2][i] * cur[i];
          const float up = bb[8 + i] + w[0][8 + i] * pp2[8 + i] + w[1][8 + i] * pp1[8 + i] + w[2][8 + i] * cur[8 + i];
          const float z = 1.5957691216057308f * (gt_ + 0.044715f * gt_ * gt_ * gt_);
          res[i] = gt_ * sigmoidf_(z) * up;
        }
        uint4 o; o.x = pack2(res[0], res[1]); o.y = pack2(res[2], res[3]); o.z = pack2(res[4], res[5]); o.w = pack2(res[6], res[7]);
        *(uint4*)(ACT + (size_t)t * 8192 + j0) = o;
      };
      one(p2, p1, c0, t0 + tt); one(p1, c0, c1, t0 + tt + 1); one(c0, c1, c2, t0 + tt + 2); one(c1, c2, c3, t0 + tt + 3);
#pragma unroll
      for (int i = 0; i < 16; ++i) { p2[i] = c2[i]; p1[i] = c3[i]; }
    }
  }
}

#define XB_TMO      128
#define XB_XCNT(j)  (256  + 64 * (j))
#define XB_XSUB(j)  (1280 + 64 * (j))
#define XB_XGEN(j)  (2304 + 64 * (j))
#define XB_TOP      3328
#define XB_TOPGEN   3392
#define XCD_BAR_WORDS 3456
#define XB_SPIN_CAP (1u << 20)
#define LAS __attribute__((address_space(3)))
DEVI unsigned xb_ld(unsigned* p)              { return __hip_atomic_load(p, __ATOMIC_RELAXED, __HIP_MEMORY_SCOPE_AGENT); }
DEVI unsigned xb_add(unsigned* p, unsigned v) { return __hip_atomic_fetch_add(p, v, __ATOMIC_RELAXED, __HIP_MEMORY_SCOPE_AGENT); }
DEVI unsigned xb_xcc_id() { return (unsigned)__builtin_amdgcn_s_getreg((3 << 11) | 20) & 0xFu; }
#define XB_SPIN(cond, bar) do { unsigned _sp = 0; while (cond) { __builtin_amdgcn_s_sleep(1); \
    if ((++_sp & 255u) == 0u) { if (xb_ld(&(bar)[XB_TMO])) break; if (_sp > XB_SPIN_CAP) { atomicAdd(&(bar)[XB_TMO], 1u); break; } } } } while (0)
struct XcdBarrier { unsigned* bar; unsigned x; volatile LAS unsigned* st; };
DEVI XcdBarrier xcd_barrier_post(unsigned* bar, volatile LAS unsigned* st) {
  XcdBarrier b; b.bar = bar; b.x = xb_xcc_id(); b.st = st;
  if (threadIdx.x == 0) (void)xb_add(&bar[XB_XCNT(b.x)], 1u);
  return b;
}
DEVI void xcd_barrier_complete(unsigned* bar, unsigned x, unsigned& nloc, unsigned& nx) {
  const unsigned G = gridDim.x * gridDim.y * gridDim.z;
  unsigned sum, cnt, mine, sp = 0u;
  for (;;) {
    sum = 0u; cnt = 0u; mine = 0u;
#pragma unroll
    for (unsigned j = 0; j < 16; ++j) { const unsigned c = xb_ld(&bar[XB_XCNT(j)]); sum += c; cnt += (c > 0u) ? 1u : 0u; mine = (j == x) ? c : mine; }
    if (sum == G) break;
    __builtin_amdgcn_s_sleep(1);
    if ((++sp & 255u) == 0u) { if (xb_ld(&bar[XB_TMO])) break; if (sp > XB_SPIN_CAP) { atomicAdd(&bar[XB_TMO], 1u); break; } }
  }
  nloc = mine > 0u ? mine : 1u; nx = cnt > 0u ? cnt : 1u;
}
DEVI void xcd_barrier(const XcdBarrier& b) {
  asm volatile("s_waitcnt vmcnt(0)" ::: "memory");
  __syncthreads();
  if (threadIdx.x == 0) {
    unsigned* bar = b.bar;
    __builtin_amdgcn_s_waitcnt(0);
    unsigned nloc = b.st[0], nx = b.st[1];
    if (nloc == 0u) { xcd_barrier_complete(bar, b.x, nloc, nx); b.st[0] = nloc; b.st[1] = nx; }
    const unsigned old = xb_add(&bar[XB_XSUB(b.x)], 1u);
    const unsigned gen = old / nloc;
    if (old + 1u == (gen + 1u) * nloc) {
      __builtin_amdgcn_fence(__ATOMIC_RELEASE, "agent");
      asm volatile("s_waitcnt vmcnt(0)" ::: "memory");
      const unsigned og = xb_add(&bar[XB_TOP], 1u);
      const unsigned tg = og / nx;
      if (og + 1u == (tg + 1u) * nx) xb_add(&bar[XB_TOPGEN], 1u);
      else XB_SPIN(xb_ld(&bar[XB_TOPGEN]) == tg, bar);
      __builtin_amdgcn_fence(__ATOMIC_ACQUIRE, "agent");
      xb_add(&bar[XB_XGEN(b.x)], 1u);
      asm volatile("s_waitcnt vmcnt(0)" ::: "memory");
    } else {
      XB_SPIN(xb_ld(&bar[XB_XGEN(b.x)]) == gen, bar);
      __builtin_amdgcn_fence(__ATOMIC_ACQUIRE, "agent");
      asm volatile("s_waitcnt vmcnt(0)" ::: "memory");
    }
  }
  __syncthreads();
}

__global__ void __launch_bounds__(512) mega(Params p_arg) {
  const Params& p = *(const Params*)__builtin_amdgcn_kernarg_segment_ptr();
  extern __shared__ __attribute__((aligned(16))) char shm[];
  cg::grid_group grid = cg::this_grid();
  const int G = gridDim.x, blk = blockIdx.x, GW = G * 8;
  char* ws = p.ws;
  if (ws == nullptr) grid.sync();
  volatile LAS unsigned* xst = (volatile LAS unsigned*)(shm + LDS_BYTES - 16);
  if (threadIdx.x == 0) { xst[0] = 0u; xst[1] = 0u; }
  __syncthreads();
  const XcdBarrier xb = xcd_barrier_post((unsigned*)(ws + O_BAR), xst);
#define GRID_SYNC() xcd_barrier(xb)
#define LOCALS const int tid = fresh_tid(), wid = tid >> 6, lane = tid & 63, gw = blk * 8 + wid; (void)gw; (void)lane; (void)wid;

  { LOCALS
    float* cscr = (float*)shm + wid * (64 * 65);
    conv_weight_lds(p.in[3], NIN, 2048, NPROJ, (bf16_t*)(ws + O_WIN), 1, gw, GW, lane, cscr, false);
    conv_weight_lds(p.in[25], 1024, 2048, 1024, (bf16_t*)(ws + O_WKV), 0, gw, GW, lane, cscr, false);
    for (int r = gw; r < TOK + 512; r += GW) {
      if (r < TOK) rms_row_bf16(p.in[0] + (size_t)r * DM, p.in[2], (bf16_t*)(ws + O_HN) + (size_t)r * DM, lane);
      else rms_row_bf16(p.in[1] + (size_t)(r - TOK) * DM, p.in[23], (bf16_t*)(ws + O_MN) + (size_t)(r - TOK) * DM, lane);
    }
    const int gt = blk * 512 + tid, GT = G * 512;
    for (int i = gt; i < 3 * TOK; i += GT) ((float*)(ws + O_SS))[i] = 0.f;
    bf16_t* wl = (bf16_t*)(ws + O_WLR);
    for (int i = gt; i < 1024 * 288; i += GT) {
      if (i < 65536) { const int c = i >> 6, k = i & 63; wl[i] = f2bf(p.in[9][k * 1024 + c]); }
      else if (i < 131072) { const int q = i - 65536, c = q >> 6, k = q & 63; wl[i] = f2bf(p.in[11][k * 1024 + c]); }
      else { const int q = i - 131072, c = q / 160, k = q % 160; wl[i] = f2bf(p.in[12][k * 1024 + c]); }
    }
  }
  GRID_SYNC();

  const bf16_t* nullbf = nullptr;
  { GD d{(const bf16_t*)(ws + O_HN), (const bf16_t*)(ws + O_WIN), 2048, 2048, 2048, 32, 42, 0, 0, ws + O_PROJ, NPROJ, (float*)(ws + O_TAIL), nullbf, nullptr};
    gemm_phase<0>(d, shm); }
  { GD d{(const bf16_t*)(ws + O_MN), (const bf16_t*)(ws + O_WKV), 2048, 2048, 2048, 2, 4, 0, 64 % G, ws + O_KV, 1024, nullptr, nullbf, nullptr};
    gemm_phase<0>(d, shm); }
  GRID_SYNC();
  for (int t = blk; t < 768; t += G) { if (t < 256) rwkv_prep_tile(p, t, shm); else mlstm_A(p, t - 256, shm); }
  GRID_SYNC();
  if (G == 256) scan_phase(p, shm);
  GRID_SYNC();
  for (int t = blk; t < 512; t += G) mlstm_D(p, t, shm);
  { LOCALS rwkv_post(p, gw, GW, lane); }
  GRID_SYNC();
  { GD da{(const bf16_t*)(ws + O_HA), (const bf16_t*)(ws + O_WA), 1024, 1024, 1024, 32, 8, 2, 0, nullptr, 0, (float*)(ws + O_MTMP), (const bf16_t*)(ws + O_PROJ) + 6144, nullptr};
    GD db{(const bf16_t*)(ws + O_HB), (const bf16_t*)(ws + O_WB), 1024, 1024, 1024, 32, 8, 3, 0, ws + O_MERGED, 2048, (float*)(ws + O_MTMP), (const bf16_t*)(ws + O_PROJ) + 8192, nullptr};
    for (int i = 0;; ++i) {
      int pm, pn;
      if (!tile_of((long)i * G + blk, 32, 8, pm, pn)) break;
      gemm_tile<2>(da, pm, pn, (lds_u8*)shm);
      gemm_tile<3>(db, pm, pn, (lds_u8*)shm);
    } }
  GRID_SYNC();
  { GD d{(const bf16_t*)(ws + O_MERGED), (const bf16_t*)(ws + O_WOUT), 2048, 2048, 2048, 32, 8, 1, 0, ws + O_Y, 2048, nullptr, nullbf, (float*)(ws + O_SS)};
    gemm_phase<1>(d, shm); }
  GRID_SYNC();
  { LOCALS
  for (int r = gw; r < TOK; r += GW)
    resid_row<false, true>(p.in[0] + (size_t)r * DM, (const bf16_t*)(ws + O_Y) + (size_t)r * DM, ((const float*)(ws + O_SS))[r], p.in[21],
              (bf16_t*)(ws + O_X1) + (size_t)r * DM, p.in[22], (bf16_t*)(ws + O_H2) + (size_t)r * DM, lane);
  float* cscr = (float*)shm + wid * (64 * 65);
  conv_weight_lds(p.in[29], 16384, 2048, 16384, (bf16_t*)(ws + O_WUP), 0, gw, GW, lane, cscr, true);
  conv_weight_lds(p.in[32], 2048, 8192, 2048, (bf16_t*)(ws + O_WDN), 0, gw, GW, lane, cscr, true); }
  GRID_SYNC();
  for (int u = blk; u < 256; u += G) {
    const int sp = u >> 6;
    GD d{(const bf16_t*)(ws + O_H2) + sp * 512, (const bf16_t*)(ws + O_WQ) + sp * 512, 2048, 2048, 512, 32, 2, 4, 0, ws + O_Q + (size_t)sp * (8 * MiB), 512, nullptr, nullbf, nullptr};
    int pm, pn;
    if (tile_of(u & 63, 32, 2, pm, pn)) gemm_tile<4>(d, pm, pn, (lds_u8*)shm);
  }
  GRID_SYNC();
  for (int t = blk; t < 256; t += G) xattn_task(p, t, shm);
  GRID_SYNC();
  { GD d{(const bf16_t*)(ws + O_O), (const bf16_t*)(ws + O_WO), 512, 512, 512, 32, 8, 1, 0, ws + O_Y, 2048, nullptr, nullbf, (float*)(ws + O_SS) + TOK};
    gemm_phase<1>(d, shm); }
  GRID_SYNC();
  { LOCALS
  for (int r = gw; r < TOK; r += GW)
    resid_row<true, true>((const bf16_t*)(ws + O_X1) + (size_t)r * DM, (const bf16_t*)(ws + O_Y) + (size_t)r * DM, ((const float*)(ws + O_SS))[TOK + r], p.in[27],
              (bf16_t*)(ws + O_X2) + (size_t)r * DM, p.in[28], (bf16_t*)(ws + O_H3) + (size_t)r * DM, lane); }
  GRID_SYNC();
  { GD d{(const bf16_t*)(ws + O_H3), (const bf16_t*)(ws + O_WUP), 2048, 2048, 2048, 32, 64, 0, 0, ws + O_U, 16384, nullptr, nullbf, nullptr};
    gemm_phase<0>(d, shm); }
  GRID_SYNC();
  { LOCALS conv_glu(p, blk * 512 + tid, G * 512); }
  GRID_SYNC();
  { GD d{(const bf16_t*)(ws + O_ACT), (const bf16_t*)(ws + O_WDN), 8192, 8192, 8192, 32, 8, 1, 0, ws + O_Y3, 2048, nullptr, nullbf, (float*)(ws + O_SS) + 2 * TOK};
    gemm_phase<1>(d, shm); }
  GRID_SYNC();
  { LOCALS
  for (int r = gw; r < TOK; r += GW)
    resid_row<true, false>((const bf16_t*)(ws + O_X2) + (size_t)r * DM, (const bf16_t*)(ws + O_Y3) + (size_t)r * DM, ((const float*)(ws + O_SS))[2 * TOK + r], p.in[33],
              p.out + (size_t)r * DM, nullptr, nullptr, lane); }
}

extern "C" void kernel_launch(void* const* d_in, const int* in_sizes, int n_in, void* d_out, int out_size, void* d_ws, size_t ws_size, hipStream_t stream) {
  static int grid_blocks = 0;
  if (!grid_blocks) {
    int dev = 0, cus = 0, per_cu = 0;
    hipGetDevice(&dev);
    hipDeviceGetAttribute(&cus, hipDeviceAttributeMultiprocessorCount, dev);
    hipFuncSetAttribute((const void*)mega, hipFuncAttributeMaxDynamicSharedMemorySize, LDS_BYTES);
    hipOccupancyMaxActiveBlocksPerMultiprocessor(&per_cu, (const void*)mega, 512, LDS_BYTES);
    if (per_cu < 1) per_cu = 1;
    grid_blocks = cus * per_cu;
    if (ws_size < 512 * MiB) fprintf(stderr, "workspace too small: %zu\n", ws_size);
  }
  (void)hipMemsetAsync((char*)d_ws + O_BAR, 0, XCD_BAR_WORDS * 4, stream);
  Params p{};
  for (int i = 0; i < 34; ++i) p.in[i] = (const float*)d_in[i];
  p.out = (float*)d_out; p.ws = (char*)d_ws;
  void* args[] = {&p};
  hipError_t e = hipLaunchCooperativeKernel((const void*)mega, dim3(grid_blocks), dim3(512), args, LDS_BYTES, stream);
  if (e != hipSuccess) fprintf(stderr, "cooperative launch failed: %s (grid %d)\n", hipGetErrorString(e), grid_blocks);
}
```

```cpp
#include <hip/hip_runtime.h>
#include <hip/hip_cooperative_groups.h>
#include <cstdio>
namespace cg = cooperative_groups;

typedef unsigned short bf16_t;
typedef short bf16x8 __attribute__((ext_vector_type(8)));
typedef float f32x4 __attribute__((ext_vector_type(4)));
typedef unsigned u32x2_t __attribute__((ext_vector_type(2)));
typedef unsigned u32x4v_t __attribute__((ext_vector_type(4)));
#define DEVI __device__ __forceinline__

constexpr int TOK = 8192, DM = 2048, SEQ = 4096, NPROJ = 10752, NIN = 10536;
constexpr int LDS_BYTES = 155648;
constexpr size_t MiB = 1048576;

constexpr size_t O_Z      = 0;
constexpr size_t O_SS     = O_Z;
constexpr size_t O_BCUM   = O_Z + 98304;
constexpr size_t O_IG     = O_BCUM + 131072;
constexpr size_t O_GMAX   = O_IG + 131072;
constexpr size_t O_BL     = O_GMAX + 2048;
constexpr size_t O_MST    = O_BL + 2048;
constexpr size_t O_DN     = O_MST + 2048;
constexpr size_t O_NST    = O_DN + 262144;
constexpr size_t O_BAR    = 917504;
constexpr size_t O_KV     = 1 * MiB;
constexpr size_t O_WLR    = 2 * MiB;
constexpr size_t O_WA     = 8 * MiB, O_WB = 12 * MiB, O_WOUT = 16 * MiB, O_WQ = 24 * MiB, O_WKV = 26 * MiB, O_WO = 30 * MiB;
constexpr size_t O_WIN    = 32 * MiB;
constexpr size_t O_HN     = 74 * MiB;
constexpr size_t O_MN     = 106 * MiB;
constexpr size_t O_DC     = 32 * MiB;
constexpr size_t O_MTMP   = 32 * MiB;
constexpr size_t O_Q      = 108 * MiB, O_O = 40 * MiB, O_H2 = 48 * MiB;
constexpr size_t O_PROJ   = 108 * MiB;
constexpr size_t O_TAIL   = 276 * MiB;
constexpr size_t O_RR     = 292 * MiB, O_RK = 308 * MiB, O_RV = 324 * MiB, O_RG = 340 * MiB, O_RKK = 356 * MiB, O_RKA = 372 * MiB, O_RW = 388 * MiB;
constexpr size_t O_HA     = 356 * MiB, O_HB = 372 * MiB;
constexpr size_t O_YS     = 420 * MiB;
constexpr size_t O_MERGED = 420 * MiB;
constexpr size_t O_CST    = 452 * MiB;
constexpr size_t O_Y      = 108 * MiB, O_X1 = 172 * MiB;
constexpr size_t O_X2     = 264 * MiB;
constexpr size_t O_WDN    = 328 * MiB;
constexpr size_t O_WUP    = 360 * MiB;
constexpr size_t O_H3     = 424 * MiB;
constexpr size_t O_U      = 8 * MiB;
constexpr size_t O_ACT    = 360 * MiB;
constexpr size_t O_Y3     = 8 * MiB;

struct Params { const float* in[34]; float* out; char* ws; };

typedef __bf16 bf16v2_t __attribute__((ext_vector_type(2)));
typedef float f32x2_t __attribute__((ext_vector_type(2)));
DEVI unsigned pack2(float a, float b) { const f32x2_t v = {a, b}; const bf16v2_t r = __builtin_convertvector(v, bf16v2_t); return __builtin_bit_cast(unsigned, r); }
DEVI bf16_t f2bf(float f) { return (bf16_t)(pack2(f, 0.f) & 0xffffu); }
DEVI unsigned pack2_sw(float a, float b) {
  unsigned u = __float_as_uint(a), w = __float_as_uint(b); u += 0x7fffu + ((u >> 16) & 1u); w += 0x7fffu + ((w >> 16) & 1u); return (u >> 16) | (w & 0xffff0000u); }
DEVI float bf2f(bf16_t b) { return __uint_as_float(((unsigned)b) << 16); }
DEVI float lo2f(unsigned u) { return __uint_as_float(u << 16); }
DEVI float hi2f(unsigned u) { return __uint_as_float(u & 0xffff0000u); }
DEVI float sigmoidf_(float x) { return 1.f / (1.f + __expf(-x)); }
DEVI float wave_sum(float v) {
#pragma unroll
  for (int o = 1; o < 64; o <<= 1) v += __shfl_xor(v, o);
  return v;
}
DEVI float dpp_sum16(float x);
DEVI float wave_sum_fast(float x) {
  x = dpp_sum16(x);
  const unsigned a = __float_as_uint(x);
  const auto r = __builtin_amdgcn_permlane16_swap(a, a, false, false);
  const float y = __uint_as_float(r[0]) + __uint_as_float(r[1]);
  const unsigned c = __float_as_uint(y);
  const auto q = __builtin_amdgcn_permlane32_swap(c, c, false, false);
  return __uint_as_float(q[0]) + __uint_as_float(q[1]);
}
DEVI float wave_max(float v) {
#pragma unroll
  for (int o = 1; o < 64; o <<= 1) v = fmaxf(v, __shfl_xor(v, o));
  return v;
}
DEVI float sum16(float v) { v += __shfl_xor(v, 1); v += __shfl_xor(v, 2); v += __shfl_xor(v, 4); v += __shfl_xor(v, 8); return v; }
DEVI float max16(float v) { v = fmaxf(v, __shfl_xor(v, 1)); v = fmaxf(v, __shfl_xor(v, 2)); v = fmaxf(v, __shfl_xor(v, 4)); v = fmaxf(v, __shfl_xor(v, 8)); return v; }
DEVI float dpp_sum16(float x) {
  x += __builtin_bit_cast(float, __builtin_amdgcn_update_dpp(0, __builtin_bit_cast(int, x), 0xB1, 0xf, 0xf, true));
  x += __builtin_bit_cast(float, __builtin_amdgcn_update_dpp(0, __builtin_bit_cast(int, x), 0x4E, 0xf, 0xf, true));
  x += __builtin_bit_cast(float, __builtin_amdgcn_update_dpp(0, __builtin_bit_cast(int, x), 0x141, 0xf, 0xf, true));
  x += __builtin_bit_cast(float, __builtin_amdgcn_update_dpp(0, __builtin_bit_cast(int, x), 0x140, 0xf, 0xf, true));
  return x;
}
DEVI int fresh_tid() { int t = threadIdx.x; asm volatile("" : "+v"(t)); return t; }
#define MFMA16(a, b, c) __builtin_amdgcn_mfma_f32_16x16x32_bf16((a), (b), (c), 0, 0, 0)

constexpr int BM = 256, BK = 64, HALF = 128, HT = HALF * BK, NXCD = 8, WGM = 4;
DEVI int lds_byte(int r, int c) { int st = (r >> 4) * 2 + (c >> 5), rr = r & 15, cc = c & 31, ob = rr * 64 + cc * 2; return st * 1024 + (ob ^ (((ob >> 9) & 1) << 5)); }
DEVI void stage_rc(int b, int& R, int& C) { int st = b / 1024, sb = b % 1024, swz = sb ^ (((sb >> 9) & 1) << 5); R = (st >> 1) * 16 + swz / 64; C = (st & 1) * 32 + (swz % 64) / 2; }

struct GD {
  const bf16_t* A; const bf16_t* Bt; int lda, ldb, K, nM, nN, mode, boff;
  void* O; int ldo; float* aux; const bf16_t* gate; float* ss;
};

DEVI bool tile_of(long L, int nM, int nN, int& pm, int& pn) {
  const int nwg = nM * nN; if (L >= nwg) return false;
  int wgid = (int)L; { const int q = nwg / NXCD, r = nwg % NXCD, xcd = wgid % NXCD, off = wgid / NXCD; wgid = (xcd < r ? xcd * (q + 1) : r * (q + 1) + (xcd - r) * q) + off; }
  const int nig = WGM * nN, gid = wgid / nig, fm = gid * WGM, gsz = (nM - fm) < WGM ? (nM - fm) : WGM;
  pm = fm + ((wgid % nig) % gsz); pn = (wgid % nig) / gsz; return true;
}

typedef __attribute__((address_space(3))) unsigned char lds_u8;
template <int MODE>
DEVI void gemm_tile(const GD& d, const int pm, const int pn, lds_u8* lds, const bool staged = false, const bool has_next = false, const int npm = 0, const int npn = 0) {
  const int tid = fresh_tid(), wid = __builtin_amdgcn_readfirstlane(tid >> 6), lane = tid & 63, wr = wid >> 2, wc = wid & 3, fr = lane & 15, fq = lane >> 4;
  const int lda = d.lda, ldb = d.ldb;
  unsigned voffA[2], voffB[2];
#pragma unroll
  for (int i = 0; i < 2; ++i) { int R, C; stage_rc(tid * 16 + i * 8192, R, C); voffA[i] = (unsigned)(R * lda + C) * 2u; voffB[i] = (unsigned)(R * ldb + C) * 2u; }
  const size_t kstep = (size_t)(BK * 2);
  const size_t hstepA = (size_t)HALF * lda * 2, hstepB = (size_t)HALF * ldb * 2;
  const unsigned ldsw = (unsigned)wid * 1024u;
  const int aoff = lds_byte(wr * 64 + fr, fq * 8), boff = lds_byte(wc * 32 + fr, fq * 8);
  constexpr int HTB = HT * 2;
#define SA(b, h) (((b) * 2 + (h)) * HTB)
#define SB(b, h) ((4 + (b) * 2 + (h)) * HTB)
#define STAGE(bufoff, gbase, voff) do { _Pragma("unroll") for (int _i = 0; _i < 2; ++_i) \
    __builtin_amdgcn_global_load_lds((const unsigned*)((const char*)(gbase) + (voff)[_i]), (__attribute__((address_space(3))) unsigned*)(lds + (bufoff) + ldsw + _i * 8192), 16, 0, 0); } while (0)
#define LDA(dst, b, h) do { _Pragma("unroll") for (int m = 0; m < 4; ++m) _Pragma("unroll") for (int k = 0; k < 2; ++k) dst[m][k] = *(const __attribute__((address_space(3))) bf16x8*)(lds + SA(b, h) + aoff + m * 2048 + k * 1024); } while (0)
#define LDB(dst, b, h) do { _Pragma("unroll") for (int n = 0; n < 2; ++n) _Pragma("unroll") for (int k = 0; k < 2; ++k) dst[n][k] = *(const __attribute__((address_space(3))) bf16x8*)(lds + SB(b, h) + boff + n * 2048 + k * 1024); } while (0)
#define MMA(ai, bj, At_, Bt_) do { __builtin_amdgcn_s_setprio(1); \
    _Pragma("unroll") for (int m = 0; m < 4; ++m) _Pragma("unroll") for (int n = 0; n < 2; ++n) _Pragma("unroll") for (int k = 0; k < 2; ++k) \
      acc[ai][bj][m][n] = MFMA16(Bt_[n][k], At_[m][k], acc[ai][bj][m][n]); \
    __builtin_amdgcn_s_setprio(0); } while (0)
#define WAIT_V(n) asm volatile("s_waitcnt vmcnt(" #n ")" ::: "memory")
#define WAIT_L(n) asm volatile("s_waitcnt lgkmcnt(" #n ")" ::: "memory")
#define BAR __builtin_amdgcn_s_barrier()
#define SCHED __builtin_amdgcn_sched_barrier(0)
  const int brow = pm * BM, bcol = pn * BM;
  const char* cA = (const char*)d.A + (size_t)brow * lda * 2;
  const char* cB = (const char*)d.Bt + (size_t)bcol * ldb * 2;
  f32x4 acc[2][2][4][2];
#pragma unroll
  for (int a = 0; a < 2; ++a)
#pragma unroll
    for (int b = 0; b < 2; ++b)
#pragma unroll
      for (int m = 0; m < 4; ++m)
#pragma unroll
        for (int n = 0; n < 2; ++n) acc[a][b][m][n] = (f32x4){0.f, 0.f, 0.f, 0.f};
  bf16x8 At[4][2], B0[2][2], B1[2][2];
  const int nt = d.K / BK;
  if (!staged) {
    STAGE(SB(0, 0), cB, voffB); STAGE(SA(0, 0), cA, voffA); STAGE(SB(0, 1), cB + hstepB, voffB); STAGE(SA(0, 1), cA + hstepA, voffA);
    if (wr == 1) BAR;
    WAIT_V(4); BAR;
    STAGE(SB(1, 0), cB + kstep, voffB); STAGE(SA(1, 0), cA + kstep, voffA); STAGE(SB(1, 1), cB + hstepB + kstep, voffB);
    WAIT_V(6); BAR;
  } else {
    if (wr == 1) BAR;
    BAR; BAR;
  }
  for (int t = 0; t < nt - 2; t += 2) {
    const char* a1 = cA + (size_t)(t + 1) * kstep;
    const char* a2 = cA + (size_t)(t + 2) * kstep; const char* b2 = cB + (size_t)(t + 2) * kstep;
    const char* a3 = a2 + kstep; const char* b3 = b2 + kstep;
    LDB(B0, 0, 0); SCHED; LDA(At, 0, 0); STAGE(SA(1, 1), a1 + hstepA, voffA);
    WAIT_L(8); BAR; WAIT_L(0); MMA(0, 0, At, B0); BAR; SCHED;
    LDB(B1, 0, 1); STAGE(SB(0, 0), b2, voffB);
    BAR; WAIT_L(0); MMA(0, 1, At, B1); BAR;
    LDA(At, 0, 1); STAGE(SA(0, 0), a2, voffA);
    BAR; WAIT_L(0); MMA(1, 0, At, B0); BAR; SCHED;
    STAGE(SB(0, 1), b2 + hstepB, voffB);
    WAIT_V(6); BAR; MMA(1, 1, At, B1); BAR;
    LDB(B0, 1, 0); SCHED; LDA(At, 1, 0); STAGE(SA(0, 1), a2 + hstepA, voffA);
    WAIT_L(8); BAR; WAIT_L(0); MMA(0, 0, At, B0); BAR; SCHED;
    LDB(B1, 1, 1); STAGE(SB(1, 0), b3, voffB);
    BAR; WAIT_L(0); MMA(0, 1, At, B1); BAR;
    LDA(At, 1, 1); STAGE(SA(1, 0), a3, voffA);
    BAR; WAIT_L(0); MMA(1, 0, At, B0); BAR; SCHED;
    STAGE(SB(1, 1), b3 + hstepB, voffB);
    WAIT_V(6); BAR; MMA(1, 1, At, B1); BAR;
  }
  { LDB(B0, 0, 0); LDA(At, 0, 0); STAGE(SA(1, 1), cA + (size_t)(nt - 1) * kstep + hstepA, voffA);
    BAR; WAIT_L(0); MMA(0, 0, At, B0); BAR;
    LDB(B1, 0, 1); BAR; WAIT_L(0); MMA(0, 1, At, B1); BAR;
    LDA(At, 0, 1); WAIT_V(4); BAR; WAIT_L(0); MMA(1, 0, At, B0); MMA(1, 1, At, B1); BAR; }
  { LDB(B0, 1, 0); LDA(At, 1, 0); WAIT_V(2); BAR; WAIT_L(0); MMA(0, 0, At, B0); BAR;
    LDB(B1, 1, 1); WAIT_V(0); BAR; WAIT_L(0); MMA(0, 1, At, B1); BAR;
    LDA(At, 1, 1); BAR; WAIT_L(0); MMA(1, 0, At, B0); MMA(1, 1, At, B1); BAR; }
  if (wr == 0) BAR;
  if (has_next) {
    const char* nA = (const char*)d.A + (size_t)npm * BM * lda * 2;
    const char* nB = (const char*)d.Bt + (size_t)npn * BM * ldb * 2;
    STAGE(SB(0, 0), nB, voffB); STAGE(SA(0, 0), nA, voffA); STAGE(SB(0, 1), nB + hstepB, voffB); STAGE(SA(0, 1), nA + hstepA, voffA);
    STAGE(SB(1, 0), nB + kstep, voffB); STAGE(SA(1, 0), nA + kstep, voffA); STAGE(SB(1, 1), nB + hstepB + kstep, voffB);
  }
  u32x4v_t gpre[2]; f32x4 tpre[2][2];
  auto ld_group = [&](int ai_, int m_) __attribute__((always_inline)) {
    const int row_ = brow + ai_ * HALF + wr * 64 + m_ * 16 + fr;
#pragma unroll
    for (int bj = 0; bj < 2; ++bj) {
      const int col_ = bcol + bj * HALF + wc * 32 + fq * 8;
      gpre[bj] = *(const u32x4v_t*)(d.gate + (size_t)row_ * NPROJ + col_);
      if (MODE == 3) { const float* mp_ = d.aux + (size_t)row_ * DM + col_; tpre[bj][0] = *(const f32x4*)mp_; tpre[bj][1] = *(const f32x4*)(mp_ + 4); }
    }
  };
  if (MODE == 2 || MODE == 3) ld_group(0, 0);
#pragma unroll
  for (int ai = 0; ai < 2; ++ai)
#pragma unroll
    for (int m = 0; m < 4; ++m) {
      const int row = brow + ai * HALF + wr * 64 + m * 16 + fr;
      u32x4v_t gcur[2]; f32x4 tcur[2][2];
      if (MODE == 2 || MODE == 3) {
        gcur[0] = gpre[0]; gcur[1] = gpre[1];
        if (MODE == 3) { tcur[0][0] = tpre[0][0]; tcur[0][1] = tpre[0][1]; tcur[1][0] = tpre[1][0]; tcur[1][1] = tpre[1][1]; }
        if (!(ai == 1 && m == 3)) ld_group(m == 3 ? ai + 1 : ai, m == 3 ? 0 : m + 1);
      }
      const int colb = bcol + wc * 32 + fq * 4;
      float ssq = 0.f;
#pragma unroll
      for (int bj = 0; bj < 2; ++bj) {
        const int col = bcol + bj * HALF + wc * 32 + fq * 8;
        const f32x4 v0 = acc[ai][bj][m][0], v1 = acc[ai][bj][m][1];
        if (MODE == 0) {
          u32x4v_t pk; pk[0] = pack2(v0[0], v0[1]); pk[1] = pack2(v0[2], v0[3]); pk[2] = pack2(v1[0], v1[1]); pk[3] = pack2(v1[2], v1[3]);
          *(u32x4v_t*)((bf16_t*)d.O + (size_t)row * d.ldo + col) = pk;
          if (d.aux != nullptr && col >= 10240) { *(f32x4*)(d.aux + (size_t)row * 512 + (col - 10240)) = v0; *(f32x4*)(d.aux + (size_t)row * 512 + (col - 10240) + 4) = v1; }
        } else if (MODE == 4) {
          u32x4v_t pk; pk[0] = pack2(v0[0], v0[1]); pk[1] = pack2(v0[2], v0[3]); pk[2] = pack2(v1[0], v1[1]); pk[3] = pack2(v1[2], v1[3]);
          *(u32x4v_t*)((bf16_t*)d.O + (size_t)row * d.ldo + col) = pk;
        } else if (MODE == 1) {
          u32x4v_t pk; pk[0] = pack2(v0[0], v0[1]); pk[1] = pack2(v0[2], v0[3]); pk[2] = pack2(v1[0], v1[1]); pk[3] = pack2(v1[2], v1[3]);
          *(u32x4v_t*)((bf16_t*)d.O + (size_t)row * d.ldo + col) = pk;
          ssq += (v0[0] * v0[0] + v0[1] * v0[1] + v0[2] * v0[2] + v0[3] * v0[3]) + (v1[0] * v1[0] + v1[1] * v1[1] + v1[2] * v1[2] + v1[3] * v1[3]);
        } else {
          const u32x4v_t g = gcur[bj];
          f32x4 s0, s1;
          s0[0] = sigmoidf_(lo2f(g[0])) * v0[0]; s0[1] = sigmoidf_(hi2f(g[0])) * v0[1]; s0[2] = sigmoidf_(lo2f(g[1])) * v0[2]; s0[3] = sigmoidf_(hi2f(g[1])) * v0[3];
          s1[0] = sigmoidf_(lo2f(g[2])) * v1[0]; s1[1] = sigmoidf_(hi2f(g[2])) * v1[1]; s1[2] = sigmoidf_(lo2f(g[3])) * v1[2]; s1[3] = sigmoidf_(hi2f(g[3])) * v1[3];
          float* mp = d.aux + (size_t)row * DM + col;
          if (MODE == 2) { *(f32x4*)mp = s0; *(f32x4*)(mp + 4) = s1; }
          else {
            const f32x4 t0 = tcur[bj][0], t1 = tcur[bj][1];
            u32x4v_t pk; pk[0] = pack2(t0[0] + s0[0], t0[1] + s0[1]); pk[1] = pack2(t0[2] + s0[2], t0[3] + s0[3]); pk[2] = pack2(t1[0] + s1[0], t1[1] + s1[1]); pk[3] = pack2(t1[2] + s1[2], t1[3] + s1[3]);
            *(u32x4v_t*)((bf16_t*)d.O + (size_t)row * d.ldo + col) = pk;
          }
        }
      }
      if (MODE == 1) {
        ssq += __shfl_xor(ssq, 16); ssq += __shfl_xor(ssq, 32);
        if (fq == 0) atomicAdd(d.ss + row, ssq);
      }
    }
  asm volatile("s_waitcnt vmcnt(0)" ::: "memory");
  __syncthreads();
}

template <int MODE>
DEVI void gemm_phase(const GD d, char* shm) {
  const int G = gridDim.x;
  const int c = (blockIdx.x + G - d.boff) % G;
  lds_u8* lds = (lds_u8*)shm;
  int pm, pn, npm = 0, npn = 0;
  bool have = tile_of((long)c, d.nM, d.nN, pm, pn), staged = false;
  for (int i = 0; have; ++i) {
    const bool has_next = tile_of((long)(i + 1) * G + c, d.nM, d.nN, npm, npn);
    gemm_tile<MODE>(d, pm, pn, lds, staged, has_next, npm, npn);
    staged = has_next; have = has_next; pm = npm; pn = npn;
  }
}

DEVI int perm32(int rho) { const int n = rho >> 4, i = rho & 15; return 8 * (i >> 2) + 4 * n + (i & 3); }

DEVI int srccol(int n, int mode) {
  if (mode == 0) return n;
  if (n < 3072) return n;
  if (n < 6144) return n + 8;
  if (n < 10240) return n + 296;
  if (n < 10528) return n - 4088;
  if (n < 10536) return n - 7456;
  return -1;
}
DEVI void conv_weight(const float* __restrict__ W, int ldw, int K, int N, bf16_t* __restrict__ Wt, int mode, int gw, int GW, int lane, const bool nts = false, const bool perm = false) {
  const int nkb = K / 64, ntask = (N / 64) * nkb;
  for (int t = gw; t < ntask; t += GW) {
    const int nb = t / nkb, kb = t % nkb;
    const int n = nb * 64 + lane; const int ns = perm ? ((n & ~31) + perm32(n & 31)) : n; const int sc = srccol(ns, mode);
    const float* src = W + (size_t)(kb * 64) * ldw + (sc < 0 ? 0 : sc);
    bf16_t* dst = Wt + (size_t)n * K + kb * 64;
#pragma unroll
    for (int j8 = 0; j8 < 8; ++j8) {
      float f[8];
#pragma unroll
      for (int j = 0; j < 8; ++j) f[j] = __builtin_nontemporal_load(src + (size_t)(j8 * 8 + j) * ldw);
      if (sc < 0) {
#pragma unroll
        for (int j = 0; j < 8; ++j) f[j] = 0.f;
      }
      u32x4v_t o; o[0] = pack2(f[0], f[1]); o[1] = pack2(f[2], f[3]); o[2] = pack2(f[4], f[5]); o[3] = pack2(f[6], f[7]);
      if (nts) __builtin_nontemporal_store(o, (u32x4v_t*)(dst + j8 * 8)); else *(u32x4v_t*)(dst + j8 * 8) = o;
    }
  }
}
DEVI void conv_weight_lds(const float* __restrict__ W, int ldw, int K, int N, bf16_t* __restrict__ Wt, int mode, int gw, int GW, int lane, float* scr, const bool nts) {
  const int nkb = K / 64, ntask = (N / 64) * nkb;
  for (int t = gw; t < ntask; t += GW) {
    const int nb = t / nkb, kb = t % nkb, n0 = nb * 64;
    const int sc = srccol(n0 + lane, mode);
    const float* src = W + (size_t)(kb * 64) * ldw + (sc < 0 ? 0 : sc);
#pragma unroll 16
    for (int j = 0; j < 64; ++j) { const float f = __builtin_nontemporal_load(src + (size_t)j * ldw); scr[j * 65 + lane] = (sc < 0) ? 0.f : f; }
    const int c = lane & 7, rsub = lane >> 3;
#pragma unroll
    for (int jj = 0; jj < 8; ++jj) {
      const int r = rsub + 8 * jj, cs = (r & ~31) + perm32(r & 31);
      const float* sp = scr + (8 * c) * 65 + cs;
      u32x4v_t o; o[0] = pack2(sp[0], sp[65]); o[1] = pack2(sp[2 * 65], sp[3 * 65]); o[2] = pack2(sp[4 * 65], sp[5 * 65]); o[3] = pack2(sp[6 * 65], sp[7 * 65]);
      bf16_t* dp = Wt + (size_t)(n0 + r) * K + kb * 64 + 8 * c;
      if (nts) __builtin_nontemporal_store(o, (u32x4v_t*)dp); else *(u32x4v_t*)dp = o;
    }
  }
}
DEVI void conv_task64(const float* __restrict__ W, int ldw, int K, bf16_t* __restrict__ Wt, int t, int lane) {
  const int nkb = K / 64, nb = t / nkb, kb = t % nkb, n = nb * 64 + lane;
  const float* src = W + (size_t)(kb * 64) * ldw + ((n & ~31) + perm32(n & 31));
  bf16_t* dst = Wt + (size_t)n * K + kb * 64;
#pragma unroll
  for (int j8 = 0; j8 < 8; ++j8) {
    float f[8];
#pragma unroll
    for (int j = 0; j < 8; ++j) f[j] = __builtin_nontemporal_load(src + (size_t)(j8 * 8 + j) * ldw);
    uint4 o; o.x = pack2(f[0], f[1]); o.y = pack2(f[2], f[3]); o.z = pack2(f[4], f[5]); o.w = pack2(f[6], f[7]);
    *(uint4*)(dst + j8 * 8) = o;
  }
}
DEVI void late_conv_task(const Params& p, int t, int lane) {
  char* ws = p.ws;
  if (t < 512) conv_task64(p.in[18], 2048, 1024, (bf16_t*)(ws + O_WA), t, lane);
  else if (t < 1024) conv_task64(p.in[19], 2048, 1024, (bf16_t*)(ws + O_WB), t - 512, lane);
  else if (t < 2048) conv_task64(p.in[20], 2048, 2048, (bf16_t*)(ws + O_WOUT), t - 1024, lane);
  else if (t < 2304) conv_task64(p.in[24], 512, 2048, (bf16_t*)(ws + O_WQ), t - 2048, lane);
  else if (t < 2560) conv_task64(p.in[26], 2048, 512, (bf16_t*)(ws + O_WO), t - 2304, lane);
}
DEVI void rms_row_bf16(const float* __restrict__ xr, const float* __restrict__ g, bf16_t* __restrict__ o, int lane) {
  f32x4 v[8]; float s = 0.f;
#pragma unroll
  for (int i = 0; i < 8; ++i) { v[i] = __builtin_nontemporal_load((const f32x4*)(xr + 4 * (lane + 64 * i))); s += v[i][0] * v[i][0] + v[i][1] * v[i][1] + v[i][2] * v[i][2] + v[i][3] * v[i][3]; }
  const float r = rsqrtf(wave_sum(s) * (1.f / 2048.f) + 1e-6f);
#pragma unroll
  for (int i = 0; i < 8; ++i) {
    const f32x4 gg = *(const f32x4*)(g + 4 * (lane + 64 * i));
    uint2 pk; pk.x = pack2(v[i][0] * r * gg[0], v[i][1] * r * gg[1]); pk.y = pack2(v[i][2] * r * gg[2], v[i][3] * r * gg[3]);
    *(uint2*)(o + 4 * (lane + 64 * i)) = pk;
  }
}
template <bool XI16, bool XO16>
DEVI void resid_row(const void* __restrict__ xi_, const bf16_t* __restrict__ y, float ssv, const float* __restrict__ gpost, void* __restrict__ xo_,
                    const float* __restrict__ gpre, bf16_t* __restrict__ ho, int lane) {
  const float r1 = rsqrtf(ssv * (1.f / 2048.f) + 1e-6f);
  f32x4 v[8]; float s = 0.f;
#pragma unroll
  for (int i = 0; i < 8; ++i) {
    const int c = 4 * (lane + 64 * i);
    f32x4 a; const f32x4 gg = *(const f32x4*)(gpost + c);
    if (XI16) { const u32x2_t xb = __builtin_nontemporal_load((const u32x2_t*)((const bf16_t*)xi_ + c)); a[0] = lo2f(xb[0]); a[1] = hi2f(xb[0]); a[2] = lo2f(xb[1]); a[3] = hi2f(xb[1]); }
    else a = __builtin_nontemporal_load((const f32x4*)((const float*)xi_ + c));
    const uint2 yb = *(const uint2*)(y + c);
    f32x4 b; b[0] = lo2f(yb.x); b[1] = hi2f(yb.x); b[2] = lo2f(yb.y); b[3] = hi2f(yb.y);
#pragma unroll
    for (int j = 0; j < 4; ++j) v[i][j] = a[j] + b[j] * r1 * gg[j];
    s += v[i][0] * v[i][0] + v[i][1] * v[i][1] + v[i][2] * v[i][2] + v[i][3] * v[i][3];
  }
#pragma unroll
  for (int i = 0; i < 8; ++i) {
    const int c = 4 * (lane + 64 * i);
    if (XO16) { u32x2_t ob; ob[0] = pack2(v[i][0], v[i][1]); ob[1] = pack2(v[i][2], v[i][3]); __builtin_nontemporal_store(ob, (u32x2_t*)((bf16_t*)xo_ + c)); }
    else __builtin_nontemporal_store(v[i], (f32x4*)((float*)xo_ + c));
  }
  if (ho != nullptr) {
    const float r = rsqrtf(wave_sum(s) * (1.f / 2048.f) + 1e-6f);
#pragma unroll
    for (int i = 0; i < 8; ++i) {
      const int c = 4 * (lane + 64 * i);
      const f32x4 gg = *(const f32x4*)(gpre + c);
      uint2 pk; pk.x = pack2(v[i][0] * r * gg[0], v[i][1] * r * gg[1]); pk.y = pack2(v[i][2] * r * gg[2], v[i][3] * r * gg[3]);
      *(uint2*)(ho + c) = pk;
    }
  }
}

DEVI void rwkv_prep_tile(const Params& p, int tile, char* shm) {
  const int tid = fresh_tid(), wid = tid >> 6, lane = tid & 63, fr = lane & 15, fq = lane >> 4;
  char* ws = p.ws;
  const float* tail = (const float*)(ws + O_TAIL);
  const bf16_t* proj = (const bf16_t*)(ws + O_PROJ);
  const float* mu = p.in[7];
  const int t0 = tile * 32;
  bf16_t* actW = (bf16_t*)shm;
  bf16_t* actA = actW + 32 * 72;
  bf16_t* actG = actA + 32 * 72;
  bf16_t* aS   = actG + 32 * 168;
  bf16x8 bfa[2][8];
  {
    const bf16_t* aupT_ = (const bf16_t*)(ws + O_WLR) + 1024 * 64;
#pragma unroll
    for (int ks = 0; ks < 2; ++ks)
#pragma unroll
      for (int n = 0; n < 8; ++n) bfa[ks][n] = *(const bf16x8*)(aupT_ + (size_t)(wid * 128 + n * 16 + fr) * 64 + ks * 32 + fq * 8);
  }
  for (int e = tid; e < 32 * 288; e += 512) {
    const int tt = e / 288, c = e % 288, t = t0 + tt;
    const float pc = tail[(size_t)t * 512 + c];
    const float pp = ((t % SEQ) > 0) ? tail[(size_t)(t - 1) * 512 + c] : 0.f;
    const float v = pc + (pp - pc) * mu[3072 + c];
    if (c < 64) actW[tt * 72 + c] = f2bf(tanhf(v));
    else if (c < 128) actA[tt * 72 + (c - 64)] = f2bf(v);
    else actG[tt * 168 + (c - 128)] = f2bf(sigmoidf_(v));
  }
  __syncthreads();
  const bf16_t* wupT = (const bf16_t*)(ws + O_WLR);
  const bf16_t* aupT = wupT + 1024 * 64;
  const bf16_t* gupT = aupT + 1024 * 64;
  const int ch0 = wid * 128;
  {
    f32x4 acc[2][8];
#pragma unroll
    for (int m = 0; m < 2; ++m)
#pragma unroll
      for (int n = 0; n < 8; ++n) acc[m][n] = (f32x4){0.f, 0.f, 0.f, 0.f};
#pragma unroll
    for (int ks = 0; ks < 2; ++ks) {
      bf16x8 af[2];
#pragma unroll
      for (int m = 0; m < 2; ++m) af[m] = *(const bf16x8*)(actA + (m * 16 + fr) * 72 + ks * 32 + fq * 8);
#pragma unroll
      for (int n = 0; n < 8; ++n) {
#pragma unroll
        for (int m = 0; m < 2; ++m) acc[m][n] = MFMA16(af[m], bfa[ks][n], acc[m][n]);
      }
    }
    const float* a0 = p.in[10];
#pragma unroll
    for (int n = 0; n < 8; ++n) {
      const int ch = ch0 + n * 16 + fr; const float a0v = a0[ch];
#pragma unroll
      for (int m = 0; m < 2; ++m)
#pragma unroll
        for (int j = 0; j < 4; ++j) aS[(m * 16 + fq * 4 + j) * 1032 + ch] = f2bf(sigmoidf_(a0v + acc[m][n][j]));
    }
  }
  {
    f32x4 acc[2][8];
#pragma unroll
    for (int m = 0; m < 2; ++m)
#pragma unroll
      for (int n = 0; n < 8; ++n) acc[m][n] = (f32x4){0.f, 0.f, 0.f, 0.f};
#pragma unroll
    for (int ks = 0; ks < 2; ++ks) {
      bf16x8 af[2];
#pragma unroll
      for (int m = 0; m < 2; ++m) af[m] = *(const bf16x8*)(actW + (m * 16 + fr) * 72 + ks * 32 + fq * 8);
#pragma unroll
      for (int n = 0; n < 8; ++n) {
        const bf16x8 bfr = *(const bf16x8*)(wupT + (size_t)(ch0 + (n >> 1) * 32 + perm32((n & 1) * 16 + fr)) * 64 + ks * 32 + fq * 8);
#pragma unroll
        for (int m = 0; m < 2; ++m) acc[m][n] = MFMA16(bfr, af[m], acc[m][n]);
      }
    }
    const float* w0 = p.in[8];
    float* RW = (float*)(ws + O_RW);
#pragma unroll
    for (int gq = 0; gq < 4; ++gq) {
      const int chb = ch0 + gq * 32 + fq * 8;
      const f32x4 w0a = *(const f32x4*)(w0 + chb), w0b = *(const f32x4*)(w0 + chb + 4);
#pragma unroll
      for (int m = 0; m < 2; ++m) {
        f32x4 oa, ob;
#pragma unroll
        for (int j = 0; j < 4; ++j) {
          const float za = -(w0a[j] + acc[m][2 * gq][j]), zb = -(w0b[j] + acc[m][2 * gq + 1][j]);
          const float spa = fmaxf(za, 0.f) + log1pf(__expf(-fabsf(za))), spb = fmaxf(zb, 0.f) + log1pf(__expf(-fabsf(zb)));
          oa[j] = __expf(-__expf(-spa - 0.5f)); ob[j] = __expf(-__expf(-spb - 0.5f));
        }
        float* dp = RW + (size_t)(t0 + m * 16 + fr) * 1024 + chb;
        *(f32x4*)dp = oa; *(f32x4*)(dp + 4) = ob;
      }
    }
  }
  {
    f32x4 acc[2][8];
#pragma unroll
    for (int m = 0; m < 2; ++m)
#pragma unroll
      for (int n = 0; n < 8; ++n) acc[m][n] = (f32x4){0.f, 0.f, 0.f, 0.f};
#pragma unroll
    for (int ks = 0; ks < 5; ++ks) {
      bf16x8 af[2];
#pragma unroll
      for (int m = 0; m < 2; ++m) af[m] = *(const bf16x8*)(actG + (m * 16 + fr) * 168 + ks * 32 + fq * 8);
#pragma unroll
      for (int n = 0; n < 8; ++n) {
        const bf16x8 bfr = *(const bf16x8*)(gupT + (size_t)(ch0 + (n >> 1) * 32 + perm32((n & 1) * 16 + fr)) * 160 + ks * 32 + fq * 8);
#pragma unroll
        for (int m = 0; m < 2; ++m) acc[m][n] = MFMA16(bfr, af[m], acc[m][n]);
      }
    }
    bf16_t* RG = (bf16_t*)(ws + O_RG);
#pragma unroll
    for (int gq = 0; gq < 4; ++gq)
#pragma unroll
      for (int m = 0; m < 2; ++m) {
        const f32x4 v0 = acc[m][2 * gq], v1 = acc[m][2 * gq + 1];
        u32x4v_t pk; pk[0] = pack2(v0[0], v0[1]); pk[1] = pack2(v0[2], v0[3]); pk[2] = pack2(v1[0], v1[1]); pk[3] = pack2(v1[2], v1[3]);
        *(u32x4v_t*)(RG + (size_t)(t0 + m * 16 + fr) * 1024 + ch0 + gq * 32 + fq * 8) = pk;
      }
  }
  __syncthreads();
  {
    bf16_t* RR = (bf16_t*)(ws + O_RR); bf16_t* RK = (bf16_t*)(ws + O_RK); bf16_t* RV = (bf16_t*)(ws + O_RV);
    bf16_t* RKK = (bf16_t*)(ws + O_RKK); bf16_t* RKA = (bf16_t*)(ws + O_RKA);
    const float* k_k = p.in[13]; const float* k_a = p.in[14];
#pragma unroll 1
    for (int hsel = 0; hsel < 2; ++hsel) {
      const int hh = wid + 8 * hsel, ch = hh * 64 + lane;
      const float mur = mu[ch], muk = mu[1024 + ch], muv = mu[2048 + ch], kkc = k_k[ch], kac = k_a[ch];
      const bf16_t* pc0 = proj + (size_t)t0 * NPROJ + 3072 + ch;
      float rp = 0.f, kp = 0.f, vp = 0.f;
      if ((t0 % SEQ) > 0) { rp = bf2f(*(pc0 - NPROJ)); kp = bf2f(*(pc0 - NPROJ + 1024)); vp = bf2f(*(pc0 - NPROJ + 2048)); }
#pragma unroll 1
      for (int tb = 0; tb < 32; tb += 4) {
        float rc[4], kc[4], vc[4], av[4];
#pragma unroll
        for (int j = 0; j < 4; ++j) {
          const bf16_t* pc = pc0 + (size_t)(tb + j) * NPROJ;
          rc[j] = bf2f(pc[0]); kc[j] = bf2f(pc[1024]); vc[j] = bf2f(pc[2048]); av[j] = bf2f(aS[(tb + j) * 1032 + ch]);
        }
#pragma unroll
        for (int j = 0; j < 4; ++j) {
          const float r = rc[j] + (rp - rc[j]) * mur, k = kc[j] + (kp - kc[j]) * muk, v = vc[j] + (vp - vc[j]) * muv, a = av[j];
          float kk = k * kkc;
          const float nrm = sqrtf(wave_sum_fast(kk * kk));
          kk = kk / fmaxf(nrm, 1e-12f);
          const float k2 = k * (1.f + (a - 1.f) * kac);
          const size_t o = (size_t)(t0 + tb + j) * 1024 + ch;
          RR[o] = f2bf(r); RK[o] = f2bf(k2); RV[o] = f2bf(v); RKK[o] = f2bf(kk); RKA[o] = f2bf(kk * a);
          rp = rc[j]; kp = kc[j]; vp = vc[j];
        }
      }
    }
  }
  __syncthreads();
}

DEVI float softcap15(float x) { const float z = x * (1.f / 15.f); return 15.f * (1.f - 2.f / (1.f + expf(2.f * z))); }

DEVI int invperm32(int d) { return 16 * ((d >> 2) & 1) + 4 * (d >> 3) + (d & 3); }
DEVI void stage_T64(const bf16_t* __restrict__ src, int ncol, bf16_t* dst, const float* sc, int tid, const bool perm = false) {
  for (int e = tid; e < 64 * ncol / 8; e += 512) {
    const int s = e & 63, cg8 = e >> 6;
    const uint4 v = *(const uint4*)(src + (size_t)s * NPROJ + cg8 * 8);
    const float f = sc ? sc[s] : 1.f;
    bf16_t* dp = dst + (perm ? ((cg8 >> 2) * 32 + (cg8 & 3) * 4) : (cg8 * 8)) * 72 + s;
    const int hi = perm ? 16 * 72 : 4 * 72;
    dp[0 * 72] = f2bf(lo2f(v.x) * f); dp[1 * 72] = f2bf(hi2f(v.x) * f); dp[2 * 72] = f2bf(lo2f(v.y) * f); dp[3 * 72] = f2bf(hi2f(v.y) * f);
    dp[hi + 0 * 72] = f2bf(lo2f(v.z) * f); dp[hi + 1 * 72] = f2bf(hi2f(v.z) * f); dp[hi + 2 * 72] = f2bf(lo2f(v.w) * f); dp[hi + 3 * 72] = f2bf(hi2f(v.w) * f);
  }
}

DEVI void mlstm_A(const Params& p, int task, char* shm) {
  const int tid = fresh_tid(), wid = tid >> 6, lane = tid & 63, fr = lane & 15, fq = lane >> 4;
  char* ws = p.ws;
  const int bh = task >> 6, c = task & 63, b = bh >> 2, h = bh & 3, t0 = b * SEQ + c * 64;
  const float* tail = (const float*)(ws + O_TAIL);
  const bf16_t* proj = (const bf16_t*)(ws + O_PROJ);
  bf16_t* vT = (bf16_t*)shm;
  bf16_t* kT = vT + 256 * 72;
  float* wsS = (float*)(kT + 128 * 72);
  uint4 vreg[4];
#pragma unroll
  for (int i = 0; i < 4; ++i) { const int e = tid + 512 * i; vreg[i] = *(const uint4*)(proj + (size_t)(t0 + (e & 63)) * NPROJ + 1024 + h * 256 + (e >> 6) * 8); }
  stage_T64(proj + (size_t)t0 * NPROJ + 512 + h * 128, 128, kT, nullptr, tid, true);
  if (wid == 0) {
    const int t = t0 + lane;
    const float ipre = tail[(size_t)t * 512 + 288 + h] + p.in[4][h];
    const float fpre = tail[(size_t)t * 512 + 292 + h] + p.in[5][h];
    const float ig = softcap15(ipre);
    const float fs = softcap15(fpre);
    const float logf = -(fmaxf(-fs, 0.f) + log1pf(expf(-fabsf(fs))));
    float bc = logf;
#pragma unroll
    for (int o = 1; o < 64; o <<= 1) { const float u = __shfl_up(bc, o); if (lane >= o) bc += u; }
    const float bL = __shfl(bc, 63);
    const float gs = bL - bc + ig;
    const float gm = wave_max(gs);
    wsS[lane] = expf(gs - gm);
    ((float*)(ws + O_BCUM))[(size_t)t * 4 + h] = bc;
    ((float*)(ws + O_IG))[(size_t)t * 4 + h] = ig;
    if (lane == 0) { ((float*)(ws + O_GMAX))[task] = gm; ((float*)(ws + O_BL))[task] = bL; }
  }
  __syncthreads();
#pragma unroll
  for (int i = 0; i < 4; ++i) {
    const int e = tid + 512 * i, s_ = e & 63, cg8 = e >> 6; const uint4 v = vreg[i]; const float f = wsS[s_];
    bf16_t* dp = vT + (cg8 * 8) * 72 + s_;
    dp[0 * 72] = f2bf(lo2f(v.x) * f); dp[1 * 72] = f2bf(hi2f(v.x) * f); dp[2 * 72] = f2bf(lo2f(v.y) * f); dp[3 * 72] = f2bf(hi2f(v.y) * f);
    dp[4 * 72] = f2bf(lo2f(v.z) * f); dp[5 * 72] = f2bf(hi2f(v.z) * f); dp[6 * 72] = f2bf(lo2f(v.w) * f); dp[7 * 72] = f2bf(hi2f(v.w) * f);
  }
  __syncthreads();
  {
    f32x4 acc[2][8];
#pragma unroll
    for (int m = 0; m < 2; ++m)
#pragma unroll
      for (int n = 0; n < 8; ++n) acc[m][n] = (f32x4){0.f, 0.f, 0.f, 0.f};
#pragma unroll
    for (int ks = 0; ks < 2; ++ks) {
      bf16x8 af[2];
#pragma unroll
      for (int m = 0; m < 2; ++m) af[m] = *(const bf16x8*)(vT + (wid * 32 + m * 16 + fr) * 72 + ks * 32 + fq * 8);
#pragma unroll
      for (int n = 0; n < 8; ++n) {
        const bf16x8 bfr = *(const bf16x8*)(kT + (n * 16 + fr) * 72 + ks * 32 + fq * 8);
#pragma unroll
        for (int m = 0; m < 2; ++m) acc[m][n] = MFMA16(bfr, af[m], acc[m][n]);
      }
    }
    bf16_t* dC = (bf16_t*)(ws + O_DC) + (size_t)task * 32768;
#pragma unroll
    for (int m = 0; m < 2; ++m)
#pragma unroll
      for (int gq = 0; gq < 4; ++gq) {
        bf16_t* dp = dC + (wid * 32 + m * 16 + fr) * 128 + gq * 32 + fq * 8;
        const f32x4 v0 = acc[m][2 * gq], v1 = acc[m][2 * gq + 1];
        u32x4v_t pk; pk[0] = pack2(v0[0], v0[1]); pk[1] = pack2(v0[2], v0[3]); pk[2] = pack2(v1[0], v1[1]); pk[3] = pack2(v1[2], v1[3]);
        __builtin_nontemporal_store(pk, (u32x4v_t*)dp);
      }
  }
  if (tid < 128) {
    float s = 0.f;
    const int krow = (tid & ~31) + invperm32(tid & 31);
    for (int i = 0; i < 64; ++i) s += wsS[i] * bf2f(kT[krow * 72 + i]);
    ((float*)(ws + O_DN))[(size_t)task * 128 + tid] = s;
  }
  __syncthreads();
}

DEVI void mlstm_scan(const Params& p, int mt, int MT) {
  char* ws = p.ws;
  const float* bLb = (const float*)(ws + O_BL); const float* gmb = (const float*)(ws + O_GMAX);
  for (int g = mt; g < 65536 + 1024; g += MT) {
    if (g < 65536) {
      const int bh = g >> 13, e4 = g & 8191;
      float m = 0.f; f32x4 C = (f32x4){0.f, 0.f, 0.f, 0.f};
      for (int c = 0; c < 64; ++c) {
        const int idx = bh * 64 + c;
        uint2 pk; pk.x = pack2(C[0], C[1]); pk.y = pack2(C[2], C[3]);
        *(uint2*)((bf16_t*)(ws + O_CST) + (size_t)idx * 32768 + e4 * 4) = pk;
        if (e4 == 0) ((float*)(ws + O_MST))[idx] = m;
        const float bL = bLb[idx], gm = gmb[idx];
        const float mn = fmaxf(bL + m, gm), cw = expf(bL + m - mn), lw = expf(gm - mn);
        const u32x2_t db = *(const u32x2_t*)((const bf16_t*)(ws + O_DC) + (size_t)idx * 32768 + e4 * 4);
        f32x4 dd; dd[0] = lo2f(db[0]); dd[1] = hi2f(db[0]); dd[2] = lo2f(db[1]); dd[3] = hi2f(db[1]);
        C = cw * C + lw * dd; m = mn;
      }
    } else {
      const int q = g - 65536, bh = q >> 7, dk = q & 127;
      float m = 0.f, n = 0.f;
      for (int c = 0; c < 64; ++c) {
        const int idx = bh * 64 + c;
        ((float*)(ws + O_NST))[(size_t)idx * 128 + dk] = n;
        const float bL = bLb[idx], gm = gmb[idx];
        const float mn = fmaxf(bL + m, gm), cw = expf(bL + m - mn), lw = expf(gm - mn);
        n = cw * n + lw * ((const float*)(ws + O_DN))[(size_t)idx * 128 + dk]; m = mn;
      }
    }
  }
}

DEVI void mlstm_D(const Params& p, int task, char* shm) {
  const int tid = fresh_tid(), wid = tid >> 6, lane = tid & 63, fr = lane & 15, fq = lane >> 4;
  char* ws = p.ws;
  const int bh = task >> 6, c = task & 63, b = bh >> 2, h = bh & 3, t0 = b * SEQ + c * 64;
  const bf16_t* proj = (const bf16_t*)(ws + O_PROJ);
  bf16_t* qS = (bf16_t*)shm;
  bf16_t* kS = qS + 64 * 136;
  bf16_t* vT = kS + 64 * 136;
  bf16_t* PS = vT + 256 * 72;
  float* fS = (float*)(PS + 64 * 72);
  float* bS = fS, *igS = fS + 64, *mtS = fS + 128, *wiS = fS + 192, *rdS = fS + 256, *nqS = fS + 320, *hsq = fS + 384, *nsS = fS + 448;
  const float scale = 0.08838834764831845f;
  const float m_s = ((const float*)(ws + O_MST))[task];
  float og[4][4][2];
#pragma unroll
  for (int m = 0; m < 4; ++m)
#pragma unroll
    for (int j = 0; j < 4; ++j)
#pragma unroll
      for (int n = 0; n < 2; ++n) og[m][j][n] = bf2f(proj[(size_t)(t0 + m * 16 + fq * 4 + j) * NPROJ + 2048 + h * 256 + wid * 32 + n * 16 + fr]);
  bf16x8 cfr[4][2];
  {
    const bf16_t* Cst0 = (const bf16_t*)(ws + O_CST) + (size_t)task * 32768;
#pragma unroll
    for (int ks = 0; ks < 4; ++ks)
#pragma unroll
      for (int n = 0; n < 2; ++n) cfr[ks][n] = *(const bf16x8*)(Cst0 + (size_t)(wid * 32 + n * 16 + fr) * 128 + ks * 32 + fq * 8);
  }
  if (tid < 64) { bS[tid] = ((const float*)(ws + O_BCUM))[(size_t)(t0 + tid) * 4 + h]; igS[tid] = ((const float*)(ws + O_IG))[(size_t)(t0 + tid) * 4 + h]; hsq[tid] = 0.f; }
  else if (tid < 192) nsS[tid - 64] = ((const float*)(ws + O_NST))[(size_t)task * 128 + (tid - 64)];
  for (int e = tid; e < 1024; e += 512) {
    const int s = e >> 4, c8 = e & 15;
    *(uint4*)(qS + s * 136 + c8 * 8) = *(const uint4*)(proj + (size_t)(t0 + s) * NPROJ + h * 128 + c8 * 8);
    *(uint4*)(kS + s * 136 + c8 * 8) = *(const uint4*)(proj + (size_t)(t0 + s) * NPROJ + 512 + h * 128 + c8 * 8);
  }
  stage_T64(proj + (size_t)t0 * NPROJ + 1024 + h * 256, 256, vT, nullptr, tid);
  __syncthreads();
  if (tid < 64) {
    float am = -INFINITY;
    for (int s = 0; s <= tid; ++s) am = fmaxf(am, igS[s] - bS[s]);
    const float mt_ = bS[tid] + fmaxf(m_s, am);
    mtS[tid] = mt_; wiS[tid] = expf(bS[tid] + m_s - mt_) * scale;
  } else if (tid < 128) {
    const int t = tid - 64; float s = 0.f;
    for (int i = 0; i < 128; ++i) s += nsS[i] * bf2f(qS[t * 136 + i]);
    nqS[t] = s;
  }
  f32x4 sacc[2];
  const int mt_i = wid >> 1, nt0 = (wid & 1) * 2;
  {
    sacc[0] = (f32x4){0.f, 0.f, 0.f, 0.f}; sacc[1] = sacc[0];
#pragma unroll
    for (int ks = 0; ks < 4; ++ks) {
      const bf16x8 af = *(const bf16x8*)(qS + (mt_i * 16 + fr) * 136 + ks * 32 + fq * 8);
#pragma unroll
      for (int n = 0; n < 2; ++n) {
        const bf16x8 bfr = *(const bf16x8*)(kS + ((nt0 + n) * 16 + fr) * 136 + ks * 32 + fq * 8);
        sacc[n] = MFMA16(af, bfr, sacc[n]);
      }
    }
  }
  __syncthreads();
#pragma unroll
  for (int n = 0; n < 2; ++n) {
    const int s = (nt0 + n) * 16 + fr;
#pragma unroll
    for (int j = 0; j < 4; ++j) {
      const int t = mt_i * 16 + fq * 4 + j;
      float pv = 0.f;
      if (s <= t) pv = sacc[n][j] * scale * expf(bS[t] - bS[s] + igS[s] - mtS[t]);
      PS[t * 72 + s] = f2bf(pv);
    }
  }
  __syncthreads();
  if (tid < 64) {
    float rs = 0.f;
    for (int s = 0; s < 64; ++s) rs += bf2f(PS[tid * 72 + s]);
    const float den = wiS[tid] * nqS[tid] + rs;
    rdS[tid] = 1.f / fmaxf(fabsf(den), expf(-mtS[tid]));
  }
  f32x4 acc[4][2];
#pragma unroll
  for (int m = 0; m < 4; ++m) { acc[m][0] = (f32x4){0.f, 0.f, 0.f, 0.f}; acc[m][1] = acc[m][0]; }
  {
#pragma unroll
    for (int ks = 0; ks < 4; ++ks) {
#pragma unroll
      for (int m = 0; m < 4; ++m) {
        const bf16x8 af = *(const bf16x8*)(qS + (m * 16 + fr) * 136 + ks * 32 + fq * 8);
#pragma unroll
        for (int n = 0; n < 2; ++n) acc[m][n] = MFMA16(af, cfr[ks][n], acc[m][n]);
      }
    }
#pragma unroll
    for (int m = 0; m < 4; ++m)
#pragma unroll
      for (int j = 0; j < 4; ++j) { const float w = wiS[m * 16 + fq * 4 + j]; acc[m][0][j] *= w; acc[m][1][j] *= w; }
#pragma unroll
    for (int ks = 0; ks < 2; ++ks) {
      bf16x8 bfr[2];
#pragma unroll
      for (int n = 0; n < 2; ++n) bfr[n] = *(const bf16x8*)(vT + (wid * 32 + n * 16 + fr) * 72 + ks * 32 + fq * 8);
#pragma unroll
      for (int m = 0; m < 4; ++m) {
        const bf16x8 af = *(const bf16x8*)(PS + (m * 16 + fr) * 72 + ks * 32 + fq * 8);
#pragma unroll
        for (int n = 0; n < 2; ++n) acc[m][n] = MFMA16(af, bfr[n], acc[m][n]);
      }
    }
  }
  __syncthreads();
#pragma unroll
  for (int m = 0; m < 4; ++m)
#pragma unroll
    for (int j = 0; j < 4; ++j) {
      const int t = m * 16 + fq * 4 + j; const float rd = rdS[t];
      acc[m][0][j] *= rd; acc[m][1][j] *= rd;
      float sq = acc[m][0][j] * acc[m][0][j] + acc[m][1][j] * acc[m][1][j];
      sq = sum16(sq);
      if (fr == 0) atomicAdd(&hsq[t], sq);
    }
  __syncthreads();
  {
    const float* hn = p.in[6];
    const float hn0 = hn[h * 256 + wid * 32 + fr], hn1 = hn[h * 256 + wid * 32 + 16 + fr];
    bf16_t* HA = (bf16_t*)(ws + O_HA);
#pragma unroll
    for (int m = 0; m < 4; ++m)
#pragma unroll
      for (int j = 0; j < 4; ++j) {
        const int t = m * 16 + fq * 4 + j; const float rn = rsqrtf(hsq[t] * (1.f / 256.f) + 1e-6f);
#pragma unroll
        for (int n = 0; n < 2; ++n) {
          const int dv = h * 256 + wid * 32 + n * 16 + fr;
          const float o = og[m][j][n];
          HA[(size_t)(t0 + t) * 1024 + dv] = f2bf(sigmoidf_(o) * acc[m][n][j] * rn * (n == 0 ? hn0 : hn1));
        }
      }
  }
  __syncthreads();
}

typedef float f32x2 __attribute__((ext_vector_type(2)));
DEVI float sum32(float x) {
  x = dpp_sum16(x);
  const unsigned a = __float_as_uint(x);
  const auto r = __builtin_amdgcn_permlane16_swap(a, a, false, false);
  return __uint_as_float(r[0]) + __uint_as_float(r[1]);
}
constexpr int SC_T = 32, SC_BUF = 41984;
constexpr int SC_PA = 0, SC_PB = 16384, SC_PC = 32768, SC_PV = 40960, SC_YP = 2 * SC_BUF, SC_YPSZ = 32768;
DEVI void scan_yreduce(const Params& p, const char* shm, int chunk, int q, int b, int h, int rowb) {
  const int s_ = q >> 3, r8 = q & 7;
  const float* yp = (const float*)(shm + SC_YP + (chunk & 1) * SC_YPSZ) + ((s_ * 4 + (r8 >> 1)) * 64 + (r8 & 1) * 32);
  f32x4 acc = (f32x4){0.f, 0.f, 0.f, 0.f};
#pragma unroll
  for (int jj = 0; jj < 8; ++jj) acc += *(const f32x4*)(yp + (((jj + q) & 7) * 4));
  ((float*)(p.ws + O_YS))[((size_t)b * SEQ + (size_t)chunk * SC_T + s_) * 1024 + h * 64 + rowb + r8] = (acc[0] + acc[1]) + (acc[2] + acc[3]);
}
struct ScanE { f32x2 w; unsigned kk, ka, k, r; };
DEVI void scan_ld1(ScanE& e, const char* ws, size_t o) {
  e.w = *(const f32x2*)((const float*)(ws + O_RW) + o); e.kk = *(const unsigned*)((const bf16_t*)(ws + O_RKK) + o); e.ka = *(const unsigned*)((const bf16_t*)(ws + O_RKA) + o);
  e.k = *(const unsigned*)((const bf16_t*)(ws + O_RK) + o); e.r = *(const unsigned*)((const bf16_t*)(ws + O_RR) + o);
}
DEVI void scan_st1(const ScanE& e, char* buf, int lE) {
  f32x4 ta, tb; ta[0] = e.w[0]; ta[1] = e.w[1]; ta[2] = lo2f(e.kk); ta[3] = hi2f(e.kk); tb[0] = lo2f(e.ka); tb[1] = hi2f(e.ka); tb[2] = lo2f(e.k); tb[3] = hi2f(e.k);
  *(f32x4*)(buf + SC_PA + lE * 16) = ta; *(f32x4*)(buf + SC_PB + lE * 16) = tb;
  *(f32x2*)(buf + SC_PC + lE * 8) = (f32x2){lo2f(e.r), hi2f(e.r)};
}
#define SCAN_LD(off) do { if (isH) { scan_ld1(E0, ws, gE + (off)); scan_ld1(E1, ws, gE + (off) + 8192); scan_ld1(E2, ws, gE + (off) + 16384); scan_ld1(E3, ws, gE + (off) + 24576); \
    Lv = ((const bf16_t*)(ws + O_RV))[gV + (off)]; } } while (0)
#define SCAN_ST(buf) do { if (isH) { scan_st1(E0, (buf), lE); scan_st1(E1, (buf), lE + 256); scan_st1(E2, (buf), lE + 512); scan_st1(E3, (buf), lE + 768); *(float*)((buf) + lV) = lo2f(Lv); } } while (0)
DEVI void scan_phase(const Params& p, char* shm) {
  const int tid = fresh_tid(), wid = tid >> 6, lane = tid & 63, blk = blockIdx.x;
  char* ws = p.ws;
  const int bh = blk >> 3, b = bh >> 4, h = bh & 15, rowb = (blk & 7) * 8;
  const bool isH = wid >= 4;
  const int hx = tid & 255;
  const size_t gE = ((size_t)b * SEQ + (hx >> 5)) * 1024 + h * 64 + (hx & 31) * 2;
  const size_t gV = ((size_t)b * SEQ + (hx >> 3)) * 1024 + h * 64 + rowb + (hx & 7);
  const int lE = hx, lV = SC_PV + hx * 4;
  const int g = blk * 256 + (tid - 256);
  const bool isC = (wid >= 4), isN = (isC && g < 1024);
  const int mbh = g >> 13, e4 = g & 8191, nbh = g >> 7, ndk = g & 127;
  float mm = 0.f, mn_ = 0.f, nn = 0.f; f32x4 C = (f32x4){0.f, 0.f, 0.f, 0.f}, dd = C; float dn = 0.f;
  const float* bLb = (const float*)(ws + O_BL); const float* gmb = (const float*)(ws + O_GMAX);
  if (isC) { const u32x2_t db = *(const u32x2_t*)((const bf16_t*)(ws + O_DC) + (size_t)(mbh * 64) * 32768 + e4 * 4); dd[0] = lo2f(db[0]); dd[1] = hi2f(db[0]); dd[2] = lo2f(db[1]); dd[3] = hi2f(db[1]); }
  float bLn = 0.f, gmn = 0.f;
  if (isC) { bLn = bLb[mbh * 64]; gmn = gmb[mbh * 64]; }
  if (isN) dn = ((const float*)(ws + O_DN))[(size_t)(nbh * 64) * 128 + ndk];
  const int rr = lane >> 5, cl = lane & 31, rowl = wid * 2 + rr;
  f32x2 st = (f32x2){0.f, 0.f};
  ScanE E0, E1, E2, E3; unsigned Lv = 0u;
  E0.w = E1.w = E2.w = E3.w = (f32x2){0.f, 0.f}; E0.kk = E0.ka = E0.k = E0.r = E1.kk = E1.ka = E1.k = E1.r = E2.kk = E2.ka = E2.k = E2.r = E3.kk = E3.ka = E3.k = E3.r = 0u;
  SCAN_LD((size_t)0);
  SCAN_ST(shm);
  SCAN_LD((size_t)SC_T * 1024);
  __syncthreads();
  for (int i = 0; i < SEQ / SC_T; ++i) {
    const bool more = (i + 1 < SEQ / SC_T);
    if (more) { char* nb = shm + ((i + 1) & 1) * SC_BUF; SCAN_ST(nb); }
    { const size_t adv = (size_t)(i + 2 < SEQ / SC_T ? i + 2 : i) * SC_T * 1024; SCAN_LD(adv); }
    if (wid < 4) {
      const char* buf = shm + (i & 1) * SC_BUF;
      float* yp = (float*)(shm + SC_YP + (i & 1) * SC_YPSZ) + wid * 64 + lane;
      const char* bA = buf + SC_PA + cl * 16; const char* bB = buf + SC_PB + cl * 16; const char* bC = buf + SC_PC + cl * 8;
      const char* bV = buf + SC_PV + rowl * 4;
      f32x4 a = *(const f32x4*)bA, bq = *(const f32x4*)bB; f32x2 r = *(const f32x2*)bC; float v = *(const float*)bV;
#pragma unroll 8
      for (int t = 0; t < SC_T; ++t) {
        const int tn = (t + 1 < SC_T) ? t + 1 : t;
        const f32x4 a2 = *(const f32x4*)(bA + tn * 512), b2 = *(const f32x4*)(bB + tn * 512);
        const f32x2 r2_ = *(const f32x2*)(bC + tn * 256); const float v2 = *(const float*)(bV + tn * 32);
        const f32x2 w = (f32x2){a[0], a[1]}, kk = (f32x2){a[2], a[3]}, ka = (f32x2){bq[0], bq[1]}, k = (f32x2){bq[2], bq[3]};
        const f32x2 pk = st * kk;
        const f32x2 tmp = st * w + v * k;
        const float sa = sum32(pk.x + pk.y);
        st = tmp - sa * ka;
        const f32x2 py = st * r;
        yp[t * 256] = py.x + py.y;
        a = a2; bq = b2; r = r2_; v = v2;
      }
    } else {
      if (i > 0) scan_yreduce(p, shm, i - 1, tid - 256, b, h, rowb);
      if (i == 9 || i == 49 || i == 89) { const int ct = blk * 4 + (wid - 4) + 1024 * (i / 40); if (ct < 2560) late_conv_task(p, ct, lane); }
    }
    if (wid >= 4 && (i & 1) == 0) {
      const int c = i >> 1, idx = mbh * 64 + c;
      {
        const float bL = bLn, gm = gmn;
        if (c < 63) { bLn = bLb[idx + 1]; gmn = gmb[idx + 1]; }
        const float mn = fmaxf(bL + mm, gm), cw = expf(bL + mm - mn), lw = expf(gm - mn);
        uint2 pk; pk.x = pack2(C[0], C[1]); pk.y = pack2(C[2], C[3]);
        *(uint2*)((bf16_t*)(ws + O_CST) + (size_t)idx * 32768 + e4 * 4) = pk;
        if (e4 == 0) ((float*)(ws + O_MST))[idx] = mm;
        C = cw * C + lw * dd;
        if (c < 63) { const u32x2_t db = __builtin_nontemporal_load((const u32x2_t*)((const bf16_t*)(ws + O_DC) + (size_t)(idx + 1) * 32768 + e4 * 4)); dd[0] = lo2f(db[0]); dd[1] = hi2f(db[0]); dd[2] = lo2f(db[1]); dd[3] = hi2f(db[1]); }
        mm = mn;
      }
      if (isN) {
        const int nidx = nbh * 64 + c;
        const float bL = bLb[nidx], gm = gmb[nidx];
        const float mn = fmaxf(bL + mn_, gm), cw = expf(bL + mn_ - mn), lw = expf(gm - mn);
        ((float*)(ws + O_NST))[(size_t)nidx * 128 + ndk] = nn;
        nn = cw * nn + lw * dn;
        if (c < 63) dn = ((const float*)(ws + O_DN))[(size_t)(nidx + 1) * 128 + ndk];
        mn_ = mn;
      }
    }
    __syncthreads();
  }
  if (wid >= 4) scan_yreduce(p, shm, SEQ / SC_T - 1, tid - 256, b, h, rowb);
  __syncthreads();
}

struct PostB { float y[4], r[4], k[4], v[4], g[4], prk[4], plg[4], plb[4]; unsigned o[4]; };
DEVI void rwkv_post(const Params& p, int gw, int GW, int lane) {
  char* ws = p.ws;
  const float* YS = (const float*)(ws + O_YS);
  const bf16_t* RR = (const bf16_t*)(ws + O_RR); const bf16_t* RK = (const bf16_t*)(ws + O_RK); const bf16_t* RV = (const bf16_t*)(ws + O_RV); const bf16_t* RG = (const bf16_t*)(ws + O_RG);
  bf16_t* HB = (bf16_t*)(ws + O_HB);
  const float* r_k = p.in[15]; const float* ln_g = p.in[16]; const float* ln_b = p.in[17];
  auto load = [&](PostB& B, int pr0) __attribute__((always_inline)) {
#pragma unroll
    for (int j = 0; j < 4; ++j) {
      const int pr = pr0 + j * GW; const int prc = pr < TOK * 16 ? pr : gw;
      const int t = prc >> 4, hh = prc & 15, ch = hh * 64 + lane; const unsigned oo = (unsigned)t * 1024u + (unsigned)ch; B.o[j] = oo;
      B.y[j] = __builtin_nontemporal_load(YS + oo); B.r[j] = bf2f(__builtin_nontemporal_load(RR + oo)); B.k[j] = bf2f(__builtin_nontemporal_load(RK + oo));
      B.v[j] = bf2f(__builtin_nontemporal_load(RV + oo)); B.g[j] = bf2f(__builtin_nontemporal_load(RG + oo));
      B.prk[j] = r_k[ch]; B.plg[j] = ln_g[ch]; B.plb[j] = ln_b[ch];
    }
  };
  PostB cur, nxt;
  load(cur, gw);
#pragma unroll 1
  for (int pr0 = gw; pr0 < TOK * 16; pr0 += 4 * GW) {
    load(nxt, (pr0 + 4 * GW < TOK * 16) ? pr0 + 4 * GW : gw);
#pragma unroll
    for (int j = 0; j < 4; ++j) {
      const float mean = wave_sum_fast(cur.y[j]) * (1.f / 64.f);
      const float dlt = cur.y[j] - mean;
      const float var = wave_sum_fast(dlt * dlt) * (1.f / 64.f);
      const float bonus = wave_sum_fast(cur.r[j] * cur.k[j] * cur.prk[j]);
      const float yn = dlt * rsqrtf(var + 64e-5f) * cur.plg[j] + cur.plb[j];
      if (pr0 + j * GW < TOK * 16) HB[cur.o[j]] = f2bf((yn + bonus * cur.v[j]) * cur.g[j]);
    }
    cur = nxt;
  }
}

DEVI void xattn_task(const Params& p, int task, char* shm) {
  const int tid = fresh_tid(), wid = tid >> 6, lane = tid & 63, fr = lane & 15, fq = lane >> 4;
  char* ws = p.ws;
  const int qt = task & 31, hd = (task >> 5) & 3, b = task >> 7;
  const bf16_t* KV = (const bf16_t*)(ws + O_KV); const bf16_t* Q = (const bf16_t*)(ws + O_Q); bf16_t* OO = (bf16_t*)(ws + O_O);
  bf16_t* VT = (bf16_t*)shm;
  bf16_t* Pw = VT + 128 * 264 + wid * (16 * 264);
  const int r0 = b * SEQ + qt * 128 + wid * 16;
  bf16x8 afq[4];
#pragma unroll
  for (int ks = 0; ks < 4; ++ks) {
    const bf16_t* qp = Q + (size_t)(r0 + fr) * 512 + hd * 128 + ks * 32 + fq * 8;
    f32x4 q0 = (f32x4){0.f, 0.f, 0.f, 0.f}, q1 = q0;
#pragma unroll
    for (int sp = 0; sp < 4; ++sp) {
      const u32x4v_t qb = *(const u32x4v_t*)(qp + (size_t)sp * (TOK * 512));
      q0[0] += lo2f(qb[0]); q0[1] += hi2f(qb[0]); q0[2] += lo2f(qb[1]); q0[3] += hi2f(qb[1]);
      q1[0] += lo2f(qb[2]); q1[1] += hi2f(qb[2]); q1[2] += lo2f(qb[3]); q1[3] += hi2f(qb[3]);
    }
    union { unsigned u[4]; bf16x8 v; } qa; qa.u[0] = pack2(q0[0], q0[1]); qa.u[1] = pack2(q0[2], q0[3]); qa.u[2] = pack2(q1[0], q1[1]); qa.u[3] = pack2(q1[2], q1[3]);
    afq[ks] = qa.v;
  }
  bf16x8 kf0[16];
#pragma unroll
  for (int n = 0; n < 16; ++n) kf0[n] = *(const bf16x8*)(KV + (size_t)(b * 256 + n * 16 + fr) * 1024 + hd * 128 + fq * 8);
  for (int e = tid; e < 4096; e += 512) {
    const int m = e & 255, dg = e >> 8;
    const uint4 v = *(const uint4*)(KV + (size_t)(b * 256 + m) * 1024 + 512 + hd * 128 + dg * 8);
    bf16_t* dp = VT + (dg * 8) * 264 + m;
    dp[0 * 264] = (bf16_t)(v.x & 0xffff); dp[1 * 264] = (bf16_t)(v.x >> 16); dp[2 * 264] = (bf16_t)(v.y & 0xffff); dp[3 * 264] = (bf16_t)(v.y >> 16);
    dp[4 * 264] = (bf16_t)(v.z & 0xffff); dp[5 * 264] = (bf16_t)(v.z >> 16); dp[6 * 264] = (bf16_t)(v.w & 0xffff); dp[7 * 264] = (bf16_t)(v.w >> 16);
  }
  __syncthreads();
  f32x4 sc[16];
#pragma unroll
  for (int n = 0; n < 16; ++n) sc[n] = (f32x4){0.f, 0.f, 0.f, 0.f};
#pragma unroll
  for (int ks = 0; ks < 4; ++ks) {
    const bf16x8 af = afq[ks];
#pragma unroll
    for (int n = 0; n < 16; ++n) {
      const bf16x8 bfr = (ks == 0) ? kf0[n] : *(const bf16x8*)(KV + (size_t)(b * 256 + n * 16 + fr) * 1024 + hd * 128 + ks * 32 + fq * 8);
      sc[n] = MFMA16(af, bfr, sc[n]);
    }
  }
  float rinv[4];
#pragma unroll
  for (int j = 0; j < 4; ++j) {
    float mx = -INFINITY;
#pragma unroll
    for (int n = 0; n < 16; ++n) mx = fmaxf(mx, sc[n][j]);
    mx = max16(mx) * 0.08838834764831845f;
    float sm = 0.f;
#pragma unroll
    for (int n = 0; n < 16; ++n) { const float e = __expf(sc[n][j] * 0.08838834764831845f - mx); sm += e; Pw[(fq * 4 + j) * 264 + n * 16 + fr] = f2bf(e); }
    rinv[j] = 1.f / sum16(sm);
  }
  __syncthreads();
  f32x4 oa[8];
#pragma unroll
  for (int n = 0; n < 8; ++n) oa[n] = (f32x4){0.f, 0.f, 0.f, 0.f};
#pragma unroll
  for (int ks = 0; ks < 8; ++ks) {
    const bf16x8 af = *(const bf16x8*)(Pw + fr * 264 + ks * 32 + fq * 8);
#pragma unroll
    for (int n = 0; n < 8; ++n) {
      const bf16x8 bfr = *(const bf16x8*)(VT + (n * 16 + fr) * 264 + ks * 32 + fq * 8);
      oa[n] = MFMA16(af, bfr, oa[n]);
    }
  }
#pragma unroll
  for (int n = 0; n < 8; ++n)
#pragma unroll
    for (int j = 0; j < 4; ++j) OO[(size_t)(r0 + fq * 4 + j) * 512 + hd * 128 + n * 16 + fr] = f2bf(oa[n][j] * rinv[j]);
  __syncthreads();
}

DEVI void conv_glu(const Params& p, int gt, int GT) {
  char* ws = p.ws;
  const bf16_t* U = (const bf16_t*)(ws + O_U); bf16_t* ACT = (bf16_t*)(ws + O_ACT);
  const float* cw = p.in[30]; const float* cb = p.in[31];
  for (int task = gt; task < 256 * 1024; task += GT) {
    const int jg = task & 1023, run = task >> 10, j0 = jg * 8, t0 = run * 32;
    float w[3][16], bb[16];
#pragma unroll
    for (int i = 0; i < 8; ++i) {
      bb[i] = cb[j0 + i]; bb[8 + i] = cb[8192 + j0 + i];
#pragma unroll
      for (int tp = 0; tp < 3; ++tp) { w[tp][i] = cw[tp * 16384 + j0 + i]; w[tp][8 + i] = cw[tp * 16384 + 8192 + j0 + i]; }
    }
    float p1[16], p2[16];
    auto ld16 = [&](int t, float* o) {
      typedef unsigned u32x4_t __attribute__((ext_vector_type(4)));
      const u32x4_t a_ = __builtin_nontemporal_load((const u32x4_t*)(U + (size_t)t * 16384 + j0)), c_ = __builtin_nontemporal_load((const u32x4_t*)(U + (size_t)t * 16384 + 8192 + j0));
      uint4 a, c; a.x = a_[0]; a.y = a_[1]; a.z = a_[2]; a.w = a_[3]; c.x = c_[0]; c.y = c_[1]; c.z = c_[2]; c.w = c_[3];
      o[0] = lo2f(a.x); o[1] = hi2f(a.x); o[2] = lo2f(a.y); o[3] = hi2f(a.y); o[4] = lo2f(a.z); o[5] = hi2f(a.z); o[6] = lo2f(a.w); o[7] = hi2f(a.w);
      o[8] = lo2f(c.x); o[9] = hi2f(c.x); o[10] = lo2f(c.y); o[11] = hi2f(c.y); o[12] = lo2f(c.z); o[13] = hi2f(c.z); o[14] = lo2f(c.w); o[15] = hi2f(c.w);
    };
    if ((t0 % SEQ) > 0) { ld16(t0 - 1, p1); ld16(t0 - 2, p2); }
    else {
#pragma unroll
      for (int i = 0; i < 16; ++i) { p1[i] = 0.f; p2[i] = 0.f; }
    }
#pragma unroll 1
    for (int tt = 0; tt < 32; tt += 4) {
      float c0[16], c1[16], c2[16], c3[16];
      ld16(t0 + tt, c0); ld16(t0 + tt + 1, c1); ld16(t0 + tt + 2, c2); ld16(t0 + tt + 3, c3);
      auto one = [&](const float* pp2, const float* pp1, const float* cur, int t) {
        float res[8];
#pragma unroll
        for (int i = 0; i < 8; ++i) {
          const float gt_ = bb[i] + w[0][i] * pp2[i] + w[1][i] * pp1[i] + w[2][i] * cur[i];
          const float up = bb[8 + i] + w[0][8 + i] * pp2[8 + i] + w[1][8 + i] * pp1[8 + i] + w[2][8 + i] * cur[8 + i];
          const float z = 1.5957691216057308f * (gt_ + 0.044715f * gt_ * gt_ * gt_);
          res[i] = gt_ * sigmoidf_(z) * up;
        }
        uint4 o; o.x = pack2(res[0], res[1]); o.y = pack2(res[2], res[3]); o.z = pack2(res[4], res[5]); o.w = pack2(res[6], res[7]);
        *(uint4*)(ACT + (size_t)t * 8192 + j0) = o;
      };
      one(p2, p1, c0, t0 + tt); one(p1, c0, c1, t0 + tt + 1); one(c0, c1, c2, t0 + tt + 2); one(c1, c2, c3, t0 + tt + 3);
#pragma unroll
      for (int i = 0; i < 16; ++i) { p2[i] = c2[i]; p1[i] = c3[i]; }
    }
  }
}

#define XB_TMO      128
#define XB_XCNT(j)  (256  + 64 * (j))
#define XB_XSUB(j)  (1280 + 64 * (j))
#define XB_XGEN(j)  (2304 + 64 * (j))
#define XB_TOP      3328
#define XB_TOPGEN   3392
#define XCD_BAR_WORDS 3456
#define XB_SPIN_CAP (1u << 20)
#define LAS __attribute__((address_space(3)))
DEVI unsigned xb_ld(unsigned* p)              { return __hip_atomic_load(p, __ATOMIC_RELAXED, __HIP_MEMORY_SCOPE_AGENT); }
DEVI unsigned xb_add(unsigned* p, unsigned v) { return __hip_atomic_fetch_add(p, v, __ATOMIC_RELAXED, __HIP_MEMORY_SCOPE_AGENT); }
DEVI unsigned xb_xcc_id() { return (unsigned)__builtin_amdgcn_s_getreg((3 << 11) | 20) & 0xFu; }
#define XB_SPIN(cond, bar) do { unsigned _sp = 0; while (cond) { __builtin_amdgcn_s_sleep(1); \
    if ((++_sp & 255u) == 0u) { if (xb_ld(&(bar)[XB_TMO])) break; if (_sp > XB_SPIN_CAP) { atomicAdd(&(bar)[XB_TMO], 1u); break; } } } } while (0)
struct XcdBarrier { unsigned* bar; unsigned x; volatile LAS unsigned* st; };
DEVI XcdBarrier xcd_barrier_post(unsigned* bar, volatile LAS unsigned* st) {
  XcdBarrier b; b.bar = bar; b.x = xb_xcc_id(); b.st = st;
  if (threadIdx.x == 0) (void)xb_add(&bar[XB_XCNT(b.x)], 1u);
  return b;
}
DEVI void xcd_barrier_complete(unsigned* bar, unsigned x, unsigned& nloc, unsigned& nx) {
  const unsigned G = gridDim.x * gridDim.y * gridDim.z;
  unsigned sum, cnt, mine, sp = 0u;
  for (;;) {
    sum = 0u; cnt = 0u; mine = 0u;
#pragma unroll
    for (unsigned j = 0; j < 16; ++j) { const unsigned c = xb_ld(&bar[XB_XCNT(j)]); sum += c; cnt += (c > 0u) ? 1u : 0u; mine = (j == x) ? c : mine; }
    if (sum == G) break;
    __builtin_amdgcn_s_sleep(1);
    if ((++sp & 255u) == 0u) { if (xb_ld(&bar[XB_TMO])) break; if (sp > XB_SPIN_CAP) { atomicAdd(&bar[XB_TMO], 1u); break; } }
  }
  nloc = mine > 0u ? mine : 1u; nx = cnt > 0u ? cnt : 1u;
}
DEVI void xcd_barrier(const XcdBarrier& b) {
  asm volatile("s_waitcnt vmcnt(0)" ::: "memory");
  __syncthreads();
  if (threadIdx.x == 0) {
    unsigned* bar = b.bar;
    __builtin_amdgcn_s_waitcnt(0);
    unsigned nloc = b.st[0], nx = b.st[1];
    if (nloc == 0u) { xcd_barrier_complete(bar, b.x, nloc, nx); b.st[0] = nloc; b.st[1] = nx; }
    const unsigned old = xb_add(&bar[XB_XSUB(b.x)], 1u);
    const unsigned gen = old / nloc;
    if (old + 1u == (gen + 1u) * nloc) {
      __builtin_amdgcn_fence(__ATOMIC_RELEASE, "agent");
      asm volatile("s_waitcnt vmcnt(0)" ::: "memory");
      const unsigned og = xb_add(&bar[XB_TOP], 1u);
      const unsigned tg = og / nx;
      if (og + 1u == (tg + 1u) * nx) xb_add(&bar[XB_TOPGEN], 1u);
      else XB_SPIN(xb_ld(&bar[XB_TOPGEN]) == tg, bar);
      __builtin_amdgcn_fence(__ATOMIC_ACQUIRE, "agent");
      xb_add(&bar[XB_XGEN(b.x)], 1u);
      asm volatile("s_waitcnt vmcnt(0)" ::: "memory");
    } else {
      XB_SPIN(xb_ld(&bar[XB_XGEN(b.x)]) == gen, bar);
      __builtin_amdgcn_fence(__ATOMIC_ACQUIRE, "agent");
      asm volatile("s_waitcnt vmcnt(0)" ::: "memory");
    }
  }
  __syncthreads();
}

__global__ void __launch_bounds__(512) mega(Params p_arg) {
  const Params& p = *(const Params*)__builtin_amdgcn_kernarg_segment_ptr();
  extern __shared__ __attribute__((aligned(16))) char shm[];
  cg::grid_group grid = cg::this_grid();
  const int G = gridDim.x, blk = blockIdx.x, GW = G * 8;
  char* ws = p.ws;
  if (ws == nullptr) grid.sync();
  volatile LAS unsigned* xst = (volatile LAS unsigned*)(shm + LDS_BYTES - 16);
  if (threadIdx.x == 0) { xst[0] = 0u; xst[1] = 0u; }
  __syncthreads();
  const XcdBarrier xb = xcd_barrier_post((unsigned*)(ws + O_BAR), xst);
#define GRID_SYNC() xcd_barrier(xb)
#define LOCALS const int tid = fresh_tid(), wid = tid >> 6, lane = tid & 63, gw = blk * 8 + wid; (void)gw; (void)lane; (void)wid;

  { LOCALS
    float* cscr = (float*)shm + wid * (64 * 65);
    conv_weight_lds(p.in[3], NIN, 2048, NPROJ, (bf16_t*)(ws + O_WIN), 1, gw, GW, lane, cscr, false);
    conv_weight_lds(p.in[25], 1024, 2048, 1024, (bf16_t*)(ws + O_WKV), 0, gw, GW, lane, cscr, false);
    for (int r = gw; r < TOK + 512; r += GW) {
      if (r < TOK) rms_row_bf16(p.in[0] + (size_t)r * DM, p.in[2], (bf16_t*)(ws + O_HN) + (size_t)r * DM, lane);
      else rms_row_bf16(p.in[1] + (size_t)(r - TOK) * DM, p.in[23], (bf16_t*)(ws + O_MN) + (size_t)(r - TOK) * DM, lane);
    }
    const int gt = blk * 512 + tid, GT = G * 512;
    for (int i = gt; i < 3 * TOK; i += GT) ((float*)(ws + O_SS))[i] = 0.f;
    bf16_t* wl = (bf16_t*)(ws + O_WLR);
    for (int i = gt; i < 1024 * 288; i += GT) {
      if (i < 65536) { const int c = i >> 6, k = i & 63; wl[i] = f2bf(p.in[9][k * 1024 + c]); }
      else if (i < 131072) { const int q = i - 65536, c = q >> 6, k = q & 63; wl[i] = f2bf(p.in[11][k * 1024 + c]); }
      else { const int q = i - 131072, c = q / 160, k = q % 160; wl[i] = f2bf(p.in[12][k * 1024 + c]); }
    }
  }
  GRID_SYNC();

  const bf16_t* nullbf = nullptr;
  { GD d{(const bf16_t*)(ws + O_HN), (const bf16_t*)(ws + O_WIN), 2048, 2048, 2048, 32, 42, 0, 0, ws + O_PROJ, NPROJ, (float*)(ws + O_TAIL), nullbf, nullptr};
    gemm_phase<0>(d, shm); }
  { GD d{(const bf16_t*)(ws + O_MN), (const bf16_t*)(ws + O_WKV), 2048, 2048, 2048, 2, 4, 0, 64 % G, ws + O_KV, 1024, nullptr, nullbf, nullptr};
    gemm_phase<0>(d, shm); }
  GRID_SYNC();
  for (int t = blk; t < 768; t += G) { if (t < 256) rwkv_prep_tile(p, t, shm); else mlstm_A(p, t - 256, shm); }
  GRID_SYNC();
  if (G == 256) scan_phase(p, shm);
  GRID_SYNC();
  for (int t = blk; t < 512; t += G) mlstm_D(p, t, shm);
  { LOCALS rwkv_post(p, gw, GW, lane); }
  GRID_SYNC();
  { GD da{(const bf16_t*)(ws + O_HA), (const bf16_t*)(ws + O_WA), 1024, 1024, 1024, 32, 8, 2, 0, nullptr, 0, (float*)(ws + O_MTMP), (const bf16_t*)(ws + O_PROJ) + 6144, nullptr};
    GD db{(const bf16_t*)(ws + O_HB), (const bf16_t*)(ws + O_WB), 1024, 1024, 1024, 32, 8, 3, 0, ws + O_MERGED, 2048, (float*)(ws + O_MTMP), (const bf16_t*)(ws + O_PROJ) + 8192, nullptr};
    for (int i = 0;; ++i) {
      int pm, pn;
      if (!tile_of((long)i * G + blk, 32, 8, pm, pn)) break;
      gemm_tile<2>(da, pm, pn, (lds_u8*)shm);
      gemm_tile<3>(db, pm, pn, (lds_u8*)shm);
    } }
  GRID_SYNC();
  { GD d{(const bf16_t*)(ws + O_MERGED), (const bf16_t*)(ws + O_WOUT), 2048, 2048, 2048, 32, 8, 1, 0, ws + O_Y, 2048, nullptr, nullbf, (float*)(ws + O_SS)};
    gemm_phase<1>(d, shm); }
  GRID_SYNC();
  { LOCALS
  for (int r = gw; r < TOK; r += GW)
    resid_row<false, true>(p.in[0] + (size_t)r * DM, (const bf16_t*)(ws + O_Y) + (size_t)r * DM, ((const float*)(ws + O_SS))[r], p.in[21],
              (bf16_t*)(ws + O_X1) + (size_t)r * DM, p.in[22], (bf16_t*)(ws + O_H2) + (size_t)r * DM, lane);
  float* cscr = (float*)shm + wid * (64 * 65);
  conv_weight_lds(p.in[29], 16384, 2048, 16384, (bf16_t*)(ws + O_WUP), 0, gw, GW, lane, cscr, true);
  conv_weight_lds(p.in[32], 2048, 8192, 2048, (bf16_t*)(ws + O_WDN), 0, gw, GW, lane, cscr, true); }
  GRID_SYNC();
  for (int u = blk; u < 256; u += G) {
    const int sp = u >> 6;
    GD d{(const bf16_t*)(ws + O_H2) + sp * 512, (const bf16_t*)(ws + O_WQ) + sp * 512, 2048, 2048, 512, 32, 2, 4, 0, ws + O_Q + (size_t)sp * (8 * MiB), 512, nullptr, nullbf, nullptr};
    int pm, pn;
    if (tile_of(u & 63, 32, 2, pm, pn)) gemm_tile<4>(d, pm, pn, (lds_u8*)shm);
  }
  GRID_SYNC();
  for (int t = blk; t < 256; t += G) xattn_task(p, t, shm);
  GRID_SYNC();
  { GD d{(const bf16_t*)(ws + O_O), (const bf16_t*)(ws + O_WO), 512, 512, 512, 32, 8, 1, 0, ws + O_Y, 2048, nullptr, nullbf, (float*)(ws + O_SS) + TOK};
    gemm_phase<1>(d, shm); }
  GRID_SYNC();
  { LOCALS
  for (int r = gw; r < TOK; r += GW)
    resid_row<true, true>((const bf16_t*)(ws + O_X1) + (size_t)r * DM, (const bf16_t*)(ws + O_Y) + (size_t)r * DM, ((const float*)(ws + O_SS))[TOK + r], p.in[27],
              (bf16_t*)(ws + O_X2) + (size_t)r * DM, p.in[28], (bf16_t*)(ws + O_H3) + (size_t)r * DM, lane); }
  GRID_SYNC();
  { GD d{(const bf16_t*)(ws + O_H3), (const bf16_t*)(ws + O_WUP), 2048, 2048, 2048, 32, 64, 0, 0, ws + O_U, 16384, nullptr, nullbf, nullptr};
    gemm_phase<0>(d, shm); }
  GRID_SYNC();
  { LOCALS conv_glu(p, blk * 512 + tid, G * 512); }
  GRID_SYNC();
  { GD d{(const bf16_t*)(ws + O_ACT), (const bf16_t*)(ws + O_WDN), 8192, 8192, 8192, 32, 8, 1, 0, ws + O_Y3, 2048, nullptr, nullbf, (float*)(ws + O_SS) + 2 * TOK};
    gemm_phase<1>(d, shm); }
  GRID_SYNC();
  { LOCALS
  for (int r = gw; r < TOK; r += GW)
    resid_row<true, false>((const bf16_t*)(ws + O_X2) + (size_t)r * DM, (const bf16_t*)(ws + O_Y3) + (size_t)r * DM, ((const float*)(ws + O_SS))[2 * TOK + r], p.in[33],
              p.out + (size_t)r * DM, nullptr, nullptr, lane); }
}

extern "C" void kernel_launch(void* const* d_in, const int* in_sizes, int n_in, void* d_out, int out_size, void* d_ws, size_t ws_size, hipStream_t stream) {
  static int grid_blocks = 0;
  if (!grid_blocks) {
    int dev = 0, cus = 0, per_cu = 0;
    hipGetDevice(&dev);
    hipDeviceGetAttribute(&cus, hipDeviceAttributeMultiprocessorCount, dev);
    hipFuncSetAttribute((const void*)mega, hipFuncAttributeMaxDynamicSharedMemorySize, LDS_BYTES);
    hipOccupancyMaxActiveBlocksPerMultiprocessor(&per_cu, (const void*)mega, 512, LDS_BYTES);
    if (per_cu < 1) per_cu = 1;
    grid_blocks = cus * per_cu;
    if (ws_size < 512 * MiB) fprintf(stderr, "workspace too small: %zu\n", ws_size);
  }
  (void)hipMemsetAsync((char*)d_ws + O_BAR, 0, XCD_BAR_WORDS * 4, stream);
  Params p{};
  for (int i = 0; i < 34; ++i) p.in[i] = (const float*)d_in[i];
  p.out = (float*)d_out; p.ws = (char*)d_ws;
  void* args[] = {&p};
  hipError_t e = hipLaunchCooperativeKernel((const void*)mega, dim3(grid_blocks), dim3(512), args, LDS_BYTES, stream);
  if (e != hipSuccess) fprintf(stderr, "cooperative launch failed: %s (grid %d)\n", hipGetErrorString(e), grid_blocks);
}
```
